# Optimizing an MI355X kernel written in HIP

```python
import math
import jax, jax.numpy as jnp
from jax import lax
import numpy as np

D_MODEL = 2048
BATCH = 2
SEQ = 8192
DEPTH = 1

D_MIX = D_MODEL
D_SSM = D_MIX // 2
SSM_GROUP = 16
N_SSM_GROUPS = D_SSM // SSM_GROUP
SSM_STATE = 64
D_ATTN = D_MIX - D_SSM
HEAD_DIM = 128
N_HEADS = D_ATTN // HEAD_DIM
N_KV_HEADS = 2
KV_REP = N_HEADS // N_KV_HEADS
N_IDX_HEADS = 16
IDX_DIM = 64
TOPK_MAX = 256
Q_BLOCK = 128
ROPE_FRAC = 4
ROPE_THETA = 500000.0
D_FF = 4 * D_MODEL
EPS = 1e-6
N_MOD = 6
IN_SPLITS = (D_SSM, N_HEADS * HEAD_DIM, N_KV_HEADS * HEAD_DIM, N_KV_HEADS * HEAD_DIM,
             N_IDX_HEADS * IDX_DIM, IDX_DIM, N_IDX_HEADS)
D_IN = D_SSM + N_HEADS * HEAD_DIM + 2 * N_KV_HEADS * HEAD_DIM + N_IDX_HEADS * IDX_DIM + IDX_DIM + N_IDX_HEADS

kernel_name = "hymba_s5_dsa_hybrid_layer"


def rms_norm(x, g):
    xf = x.astype(jnp.float32)
    y = xf * lax.rsqrt(jnp.mean(xf * xf, axis=-1, keepdims=True) + EPS)
    return (y * g.astype(jnp.float32)).astype(x.dtype)


def partial_rope(x, pos):
    d = x.shape[-1]
    r = d // ROPE_FRAC
    half = r // 2
    inv = ROPE_THETA ** (-jnp.arange(half, dtype=jnp.float32) / half)
    ang = pos.astype(jnp.float32)[..., None] * inv
    cos = jnp.cos(ang)[:, :, None, :]
    sin = jnp.sin(ang)[:, :, None, :]
    x1 = x[..., :half].astype(jnp.float32)
    x2 = x[..., half:r].astype(jnp.float32)
    rot = jnp.concatenate([x1 * cos - x2 * sin, x1 * sin + x2 * cos], axis=-1).astype(x.dtype)
    return jnp.concatenate([rot, x[..., r:]], axis=-1)


def s5_mixer(u, lam_re, lam_im, log_dt, b_re, b_im, c_re, c_im, d_skip, w_glu, b_glu):
    bsz, seq, _ = u.shape
    f32 = jnp.float32
    uf = u.astype(f32).reshape(bsz, seq, N_SSM_GROUPS, SSM_GROUP)
    lr = jnp.minimum(lam_re.astype(f32), -1e-4)
    li = lam_im.astype(f32)
    dt = jnp.exp(log_dt.astype(f32))[:, None]
    mag = jnp.exp(lr * dt)
    abar_r = mag * jnp.cos(li * dt)
    abar_i = mag * jnp.sin(li * dt)
    den = lr * lr + li * li
    fr = ((abar_r - 1.0) * lr + abar_i * li) / den
    fi = (abar_i * lr - (abar_r - 1.0) * li) / den
    bu_r = jnp.einsum('blgh,gph->blgp', uf, b_re.astype(f32))
    bu_i = jnp.einsum('blgh,gph->blgp', uf, b_im.astype(f32))
    xr0 = fr * bu_r - fi * bu_i
    xi0 = fr * bu_i + fi * bu_r
    a_r = jnp.broadcast_to(abar_r, xr0.shape)
    a_i = jnp.broadcast_to(abar_i, xr0.shape)

    def combine(e1, e2):
        a1r, a1i, b1r, b1i = e1
        a2r, a2i, b2r, b2i = e2
        return (a2r * a1r - a2i * a1i,
                a2r * a1i + a2i * a1r,
                a2r * b1r - a2i * b1i + b2r,
                a2r * b1i + a2i * b1r + b2i)

    _, _, s_r, s_i = lax.associative_scan(combine, (a_r, a_i, xr0, xi0), axis=1)
    y = (jnp.einsum('blgp,ghp->blgh', s_r, c_re.astype(f32))
         - jnp.einsum('blgp,ghp->blgh', s_i, c_im.astype(f32)))
    y = y.reshape(bsz, seq, D_SSM) + d_skip.astype(f32) * u.astype(f32)
    ya = jax.nn.gelu(y)
    out = ya * jax.nn.sigmoid(ya @ w_glu.astype(f32) + b_glu.astype(f32))
    return out.astype(u.dtype)


def dsa_attention(q, k, v, q_idx, k_idx, w_idx, topk):
    f32 = jnp.float32
    bsz, seq = q.shape[:2]
    n_blocks = seq // Q_BLOCK
    key_pos = jnp.arange(seq)
    bidx = jnp.arange(bsz)[:, None, None]
    k_idx_f = k_idx.astype(f32)
    idx_scale = IDX_DIM ** -0.5
    head_w_scale = N_IDX_HEADS ** -0.5
    attn_scale = HEAD_DIM ** -0.5

    def block(i):
        start = i * Q_BLOCK
        qb = lax.dynamic_slice_in_dim(q, start, Q_BLOCK, axis=1)
        qib = lax.dynamic_slice_in_dim(q_idx, start, Q_BLOCK, axis=1).astype(f32)
        wb = lax.dynamic_slice_in_dim(w_idx, start, Q_BLOCK, axis=1).astype(f32) * head_w_scale
        logits = jnp.einsum('bqhd,bkd->bqhk', qib, k_idx_f) * idx_scale
        isc = jnp.einsum('bqhk,bqh->bqk', jax.nn.relu(logits), wb)
        qpos = start + jnp.arange(Q_BLOCK)
        causal = key_pos[None, :] <= qpos[:, None]
        isc = jnp.where(causal[None], isc, -jnp.inf)
        top_val, top_idx = lax.top_k(isc, topk)
        valid = jnp.isfinite(top_val)
        ks = k[bidx, top_idx].astype(f32)
        vs = v[bidx, top_idx].astype(f32)
        qg = qb.reshape(bsz, Q_BLOCK, N_KV_HEADS, KV_REP, HEAD_DIM).astype(f32)
        sc = jnp.einsum('bqgrd,bqkgd->bqgrk', qg, ks) * attn_scale
        sc = jnp.where(valid[:, :, None, None, :], sc, -jnp.inf)
        p = jax.nn.softmax(sc, axis=-1)
        o = jnp.einsum('bqgrk,bqkgd->bqgrd', p, vs)
        return o.reshape(bsz, Q_BLOCK, N_HEADS * HEAD_DIM).astype(q.dtype)

    out = lax.map(block, jnp.arange(n_blocks))
    return out.transpose(1, 0, 2, 3).reshape(bsz, seq, N_HEADS * HEAD_DIM)


def setup_inputs(seed: int = 0) -> dict:
    key = jax.random.key(seed)
    ks = jax.random.split(key, 32)
    f32 = jnp.float32
    nrm = lambda k, shape, s: jax.random.normal(k, shape, f32) * s
    G, P, H = N_SSM_GROUPS, SSM_STATE, SSM_GROUP
    x = jax.random.normal(ks[0], (BATCH, SEQ, D_MODEL), f32)
    c = jax.random.normal(ks[1], (BATCH, D_MODEL), f32)
    offset = jax.random.randint(ks[2], (BATCH, 1), 0, 1024)
    positions = (offset + jnp.arange(SEQ, dtype=jnp.int32)[None, :]).astype(jnp.int32)
    lam_im = jnp.broadcast_to(math.pi * jnp.arange(P, dtype=f32), (DEPTH, G, P))
    return {
        "x": x,
        "c": c,
        "positions": positions,
        "w_ada": nrm(ks[3], (DEPTH, D_MODEL, N_MOD * D_MODEL), 0.5 * D_MODEL ** -0.5),
        "b_ada": nrm(ks[4], (DEPTH, N_MOD * D_MODEL), 0.02),
        "g_norm_mix": 1.0 + nrm(ks[5], (DEPTH, D_MODEL), 0.02),
        "w_in": nrm(ks[6], (DEPTH, D_MODEL, D_IN), D_MODEL ** -0.5),
        "lam_re": -0.5 + nrm(ks[7], (DEPTH, G, P), 0.01),
        "lam_im": lam_im,
        "log_dt": jax.random.uniform(ks[8], (DEPTH, G), f32, math.log(1e-3), math.log(1e-1)),
        "b_re": nrm(ks[9], (DEPTH, G, P, H), (2 * H) ** -0.5),
        "b_im": nrm(ks[10], (DEPTH, G, P, H), (2 * H) ** -0.5),
        "c_re": nrm(ks[11], (DEPTH, G, H, P), (2 * P) ** -0.5),
        "c_im": nrm(ks[12], (DEPTH, G, H, P), (2 * P) ** -0.5),
        "d_skip": nrm(ks[13], (DEPTH, D_SSM), 1.0),
        "w_glu": nrm(ks[14], (DEPTH, D_SSM, D_SSM), D_SSM ** -0.5),
        "b_glu": nrm(ks[15], (DEPTH, D_SSM), 0.02),
        "g_q": 1.0 + nrm(ks[16], (DEPTH, HEAD_DIM), 0.02),
        "g_k": 1.0 + nrm(ks[17], (DEPTH, HEAD_DIM), 0.02),
        "g_out_ssm": 1.0 + nrm(ks[18], (DEPTH, D_SSM), 0.02),
        "g_out_attn": 1.0 + nrm(ks[19], (DEPTH, D_ATTN), 0.02),
        "w_out": nrm(ks[20], (DEPTH, D_MIX, D_MODEL), D_MIX ** -0.5),
        "g_norm_mlp": 1.0 + nrm(ks[21], (DEPTH, D_MODEL), 0.02),
        "w_mlp_in": nrm(ks[22], (DEPTH, D_MODEL, D_FF), D_MODEL ** -0.5),
        "w_mlp_out": nrm(ks[23], (DEPTH, D_FF, D_MODEL), D_FF ** -0.5),
    }


def reference(x, c, positions, w_ada, b_ada, g_norm_mix, w_in, lam_re, lam_im, log_dt,
              b_re, b_im, c_re, c_im, d_skip, w_glu, b_glu, g_q, g_k, g_out_ssm, g_out_attn,
              w_out, g_norm_mlp, w_mlp_in, w_mlp_out):
    bsz, seq, _ = x.shape
    topk = min(TOPK_MAX, seq // 4)
    split_pts = [int(s) for s in np.cumsum(IN_SPLITS)[:-1]]
    c_act = jax.nn.silu(c.astype(jnp.float32))
    for l in range(DEPTH):
        mod = c_act @ w_ada[l].astype(jnp.float32) + b_ada[l].astype(jnp.float32)
        sh_a, sc_a, gt_a, sh_m, sc_m, gt_m = [m[:, None, :] for m in jnp.split(mod, N_MOD, axis=-1)]

        h = (rms_norm(x, g_norm_mix[l]).astype(jnp.float32) * (1.0 + sc_a) + sh_a).astype(x.dtype)
        proj = h @ w_in[l]
        u_ssm, q, k, v, q_i, k_i, w_i = jnp.split(proj, split_pts, axis=-1)

        y_ssm = s5_mixer(u_ssm, lam_re[l], lam_im[l], log_dt[l], b_re[l], b_im[l],
                         c_re[l], c_im[l], d_skip[l], w_glu[l], b_glu[l])

        q = partial_rope(rms_norm(q.reshape(bsz, seq, N_HEADS, HEAD_DIM), g_q[l]), positions)
        k = partial_rope(rms_norm(k.reshape(bsz, seq, N_KV_HEADS, HEAD_DIM), g_k[l]), positions)
        v = v.reshape(bsz, seq, N_KV_HEADS, HEAD_DIM)
        q_i = partial_rope(q_i.reshape(bsz, seq, N_IDX_HEADS, IDX_DIM), positions)
        k_i = partial_rope(k_i.reshape(bsz, seq, 1, IDX_DIM), positions)[:, :, 0, :]
        y_attn = dsa_attention(q, k, v, q_i, k_i, w_i, topk)

        mix = jnp.concatenate([rms_norm(y_ssm, g_out_ssm[l]), rms_norm(y_attn, g_out_attn[l])], axis=-1)
        x = (x + gt_a * (mix @ w_out[l])).astype(x.dtype)

        h2 = (rms_norm(x, g_norm_mlp[l]).astype(jnp.float32) * (1.0 + sc_m) + sh_m).astype(x.dtype)
        ff = jnp.square(jax.nn.relu(h2 @ w_mlp_in[l])) @ w_mlp_out[l]
        x = (x + gt_m * ff).astype(x.dtype)
    return x
```

```cpp
#include <hip/hip_runtime.h>
#include <cstdio>
#include <cmath>

#ifndef MK_N_LAUNCHES
#define MK_N_LAUNCHES 1
#endif

#define LAS __attribute__((address_space(3)))
#define GAS __attribute__((address_space(1)))
typedef _Float16 f16;
typedef _Float16 half8 __attribute__((ext_vector_type(8)));
typedef _Float16 half4 __attribute__((ext_vector_type(4)));
typedef _Float16 half2v __attribute__((ext_vector_type(2)));
typedef float f32x2 __attribute__((ext_vector_type(2)));
typedef float f32x4 __attribute__((ext_vector_type(4)));
typedef float f32x16 __attribute__((ext_vector_type(16)));
typedef unsigned u32x2 __attribute__((ext_vector_type(2)));
typedef unsigned u32x4 __attribute__((ext_vector_type(4)));
typedef unsigned short u16;
typedef int i32x4 __attribute__((ext_vector_type(4)));
constexpr float QK8_S = 127.0f / 6.0f;
constexpr float V8_S = 127.0f / 8.0f;
constexpr float HA8_S = 127.0f / 6.5f;
constexpr float XA8_S = 127.0f / 6.5f;
constexpr float WU8_S = 127.0f / 0.105f;
constexpr float H8_S = 255.0f / 24.0f;
constexpr float WD8_S = 127.0f / 0.0525f;

constexpr int D = 2048, BATCH = 2, SEQ = 8192, M = BATCH * SEQ;
constexpr int D_SSM = 1024, NG = 64, SG = 16, SP = 64, D_ATTN = 1024, HD = 128, NH = 8, NKV = 2;
constexpr int NIH = 16, ID = 64, TOPK = 256, D_FF = 8192, N_MOD = 6;
constexpr int D_IN = 3664, D_INP = 3840;
constexpr int CT = 32, NCH = SEQ / CT;
constexpr float EPS = 1e-6f;
constexpr float WSC = 64.f, WSC_INV = 1.f / 64.f;
constexpr float TSC = 1024.f, TSC_INV = 1.f / 1024.f;

constexpr size_t MiB = 1u << 20;
constexpr size_t WS_CTL = 0, CTL_ZERO_BYTES = 1 * MiB;
constexpr size_t WS_SMALL = 1 * MiB;
constexpr size_t WS_WUP = 2 * MiB, WS_WDN = 34 * MiB, WS_X16 = 66 * MiB;
constexpr size_t WS_WIN = 130 * MiB, WS_WGLU = 145 * MiB, WS_WOUT = 147 * MiB, WS_T1 = 155 * MiB, WS_WY = 203 * MiB;
constexpr size_t WS_U16 = 219 * MiB, WS_Q16 = 251 * MiB, WS_K16 = 283 * MiB, WS_V16 = 291 * MiB, WS_QI32 = 299 * MiB, WS_KW32 = 363 * MiB;
constexpr size_t WS_KI16 = 379 * MiB, WS_WI32 = 381 * MiB, WS_YIN = 382 * MiB, WS_E32 = 414 * MiB, WS_SPREV = 430 * MiB, WS_SEL = 446 * MiB;
constexpr size_t WS_H8 = WS_YIN;
constexpr size_t WS_WIN8 = WS_SPREV;
constexpr size_t WS_MIX = WS_QI32;
constexpr size_t WS_HFF = 130 * MiB;
constexpr size_t WS_X1H = 386 * MiB;
constexpr size_t WS_K8 = WS_X16, WS_V8 = WS_X16 + 4 * MiB;
constexpr size_t WS_END = 454 * MiB;
constexpr int CW_BAR = 4096;
constexpr int CW_QH = 8192;
constexpr int CW_ATT = 8256;
constexpr int CW_IXQ = 8640;
constexpr int CW_G2Q = 8512;
constexpr int CW_SCAN = 8208;
constexpr int CW_RSS = 32768;
constexpr int CW_RSX = 32768 + 16384;
constexpr int CW_RSA2 = CW_RSX + 16384;
static_assert((CW_RSA2 + 32768) * 4 <= (int)CTL_ZERO_BYTES, "ctl");
constexpr int SM_MODP = 0;
constexpr int SM_VEC = 8 * 2 * 12288;
constexpr int SM_BIAS2 = SM_VEC + 2 * 6 * 2048;
constexpr int SM_LAMT = SM_BIAS2 + 2 * 8192;
constexpr int SM_CSUM = SM_LAMT + 64 * 64 * 2;
static_assert((SM_CSUM + 2048) * 4 <= (int)MiB, "small");

constexpr int RING_BYTES = 131072;
constexpr int MISC_OFF = 159744;
constexpr int LDS_BYTES = MISC_OFF + 256;

#define RLX_AGENT __ATOMIC_RELAXED, __HIP_MEMORY_SCOPE_AGENT
#define LDS_WAIT() asm volatile("s_waitcnt lgkmcnt(0)" ::: "memory")
#define VM_WAIT() asm volatile("s_waitcnt vmcnt(0)" ::: "memory")

#define XB_TMO      128
#define XB_XCNT(j)  (256  + 64 * (j))
#define XB_XSUB(j)  (1280 + 64 * (j))
#define XB_XGEN(j)  (2304 + 64 * (j))
#define XB_TOP      3328
#define XB_TOPGEN   3392
#define XCD_BAR_WORDS 3456
#define XB_SPIN_CAP (1u << 22)
__device__ __forceinline__ unsigned xb_ld(unsigned* p)              { return __hip_atomic_load(p, __ATOMIC_RELAXED, __HIP_MEMORY_SCOPE_AGENT); }
__device__ __forceinline__ unsigned xb_add(unsigned* p, unsigned v) { return __hip_atomic_fetch_add(p, v, __ATOMIC_RELAXED, __HIP_MEMORY_SCOPE_AGENT); }
__device__ __forceinline__ unsigned xb_xcc_id() { return (unsigned)__builtin_amdgcn_s_getreg((3 << 11) | 20) & 0xFu; }
#define XB_SPIN(cond, bar) do { unsigned _sp = 0; while (cond) { __builtin_amdgcn_s_sleep(1); \
    if ((++_sp & 255u) == 0u) { if (xb_ld(&(bar)[XB_TMO])) break; if (_sp > XB_SPIN_CAP) { atomicAdd(&(bar)[XB_TMO], 1u); break; } } } } while (0)
struct XcdBarrier { unsigned* bar; unsigned x; volatile LAS unsigned* st; };
__device__ __forceinline__ XcdBarrier xcd_barrier_post(unsigned* bar, volatile LAS unsigned* st) {
    XcdBarrier b; b.bar = bar; b.x = xb_xcc_id(); b.st = st;
    if (threadIdx.x == 0) (void)xb_add(&bar[XB_XCNT(b.x)], 1u);
    return b;
}
__device__ __forceinline__ void xcd_barrier_complete(unsigned* bar, unsigned x, unsigned& nloc, unsigned& nx) {
    const unsigned G = gridDim.x * gridDim.y * gridDim.z;
    unsigned sum, cnt, mine, sp = 0u;
    for (;;) {
        sum = 0u; cnt = 0u; mine = 0u;
#pragma unroll
        for (unsigned j = 0; j < 16; ++j) { const unsigned c = xb_ld(&bar[XB_XCNT(j)]); sum += c; cnt += (c > 0u) ? 1u : 0u; mine = (j == x) ? c : mine; }
        if (sum == G) break;
        __builtin_amdgcn_s_sleep(1);
        if ((++sp & 255u) == 0u) { if (xb_ld(&bar[XB_TMO])) break; if (sp > XB_SPIN_CAP) { atomicAdd(&bar[XB_TMO], 1u); break; } }
    }
    nloc = mine > 0u ? mine : 1u; nx = cnt > 0u ? cnt : 1u;
}
__device__ __forceinline__ void xcd_barrier(const XcdBarrier& b) {
    asm volatile("s_waitcnt vmcnt(0)" ::: "memory");
    __syncthreads();
    if (threadIdx.x == 0) {
        unsigned* bar = b.bar;
        __builtin_amdgcn_s_waitcnt(0);
        unsigned nloc = b.st[0], nx = b.st[1];
        if (nloc == 0u) { xcd_barrier_complete(bar, b.x, nloc, nx); b.st[0] = nloc; b.st[1] = nx; }
        const unsigned old = xb_add(&bar[XB_XSUB(b.x)], 1u);
        const unsigned gen = old / nloc;
        if (old + 1u == (gen + 1u) * nloc) {
            __builtin_amdgcn_fence(__ATOMIC_RELEASE, "agent");
            asm volatile("s_waitcnt vmcnt(0)" ::: "memory");
            const unsigned og = xb_add(&bar[XB_TOP], 1u);
            const unsigned tg = og / nx;
            if (og + 1u == (tg + 1u) * nx) xb_add(&bar[XB_TOPGEN], 1u);
            else XB_SPIN(xb_ld(&bar[XB_TOPGEN]) == tg, bar);
            __builtin_amdgcn_fence(__ATOMIC_ACQUIRE, "agent");
            xb_add(&bar[XB_XGEN(b.x)], 1u);
            asm volatile("s_waitcnt vmcnt(0)" ::: "memory");
        } else {
            XB_SPIN(xb_ld(&bar[XB_XGEN(b.x)]) == gen, bar);
            __builtin_amdgcn_fence(__ATOMIC_ACQUIRE, "agent");
            asm volatile("s_waitcnt vmcnt(0)" ::: "memory");
        }
    }
    __syncthreads();
}

__device__ __forceinline__ float wave_sum(float v) {
#pragma unroll
    for (int o = 1; o < 64; o <<= 1) v += __shfl_xor(v, o);
    return v;
}
__device__ __forceinline__ half2v u2h(const unsigned x) { return __builtin_bit_cast(half2v, x); }
__device__ __forceinline__ unsigned pkh(float a, float b) { half2v h = {(f16)a, (f16)b}; return __builtin_bit_cast(unsigned, h); }
__device__ __forceinline__ u32x4 pk8(const f32x4 a, const f32x4 b) { u32x4 w; w.x = pkh(a[0], a[1]); w.y = pkh(a[2], a[3]); w.z = pkh(b[0], b[1]); w.w = pkh(b[2], b[3]); return w; }
__device__ __forceinline__ void unpk8(const u32x4 w, float (&o)[8]) {
    const half8 h = __builtin_bit_cast(half8, w);
#pragma unroll
    for (int i = 0; i < 8; ++i) o[i] = (float)h[i];
}
__device__ __forceinline__ unsigned pk4i8(float a, float b, float c, float d, const float S = QK8_S) {
    const int ia = (int)__builtin_rintf(fminf(fmaxf(a * S, -127.f), 127.f)), ib = (int)__builtin_rintf(fminf(fmaxf(b * S, -127.f), 127.f));
    const int ic = (int)__builtin_rintf(fminf(fmaxf(c * S, -127.f), 127.f)), id = (int)__builtin_rintf(fminf(fmaxf(d * S, -127.f), 127.f));
    return (unsigned)(ia & 255) | ((unsigned)(ib & 255) << 8) | ((unsigned)(ic & 255) << 16) | ((unsigned)(id & 255) << 24);
}
__device__ __forceinline__ unsigned pk4u8m128(float a, float b, float c, float d, const float S) {
    unsigned w = 0u;
    w = __builtin_amdgcn_cvt_pk_u8_f32(a * S, 0u, w); w = __builtin_amdgcn_cvt_pk_u8_f32(b * S, 1u, w); w = __builtin_amdgcn_cvt_pk_u8_f32(c * S, 2u, w); w = __builtin_amdgcn_cvt_pk_u8_f32(d * S, 3u, w);
    return w ^ 0x80808080u;
}
__device__ __forceinline__ float sigmoidf_(float x) { return 1.0f / (1.0f + __expf(-x)); }
__device__ __forceinline__ float gelu_tanh(float y) { const float z = 0.7978845608028654f * (y + 0.044715f * y * y * y); const float t = 1.0f - 2.0f / (1.0f + __expf(2.0f * z)); return 0.5f * y * (1.0f + t); }
__device__ __forceinline__ double dexp(double x) {
    const double y = x * (1.0 / 1024.0); double s = 1.0 + y * (1.0 + y * (0.5 + y * ((1.0 / 6.0) + y * ((1.0 / 24.0) + y * ((1.0 / 120.0) + y * ((1.0 / 720.0) + y * (1.0 / 5040.0)))))));
#pragma unroll 1
    for (int i = 0; i < 10; ++i) s *= s;
    return s;
}
__device__ __forceinline__ void dsincos(double a, double& sn, double& cs) {
    const double TWO_PI = 6.283185307179586476925286766559;
    const double k = rint(a * (1.0 / TWO_PI)); double r = a - k * TWO_PI;
    r *= 0.125;
    const double r2 = r * r;
    double c = 1.0 + r2 * (-1.0 / 2.0 + r2 * (1.0 / 24.0 + r2 * (-1.0 / 720.0 + r2 * (1.0 / 40320.0 + r2 * (-1.0 / 3628800.0 + r2 * (1.0 / 479001600.0 + r2 * (-1.0 / 87178291200.0)))))));
    double s = r * (1.0 + r2 * (-1.0 / 6.0 + r2 * (1.0 / 120.0 + r2 * (-1.0 / 5040.0 + r2 * (1.0 / 362880.0 + r2 * (-1.0 / 39916800.0 + r2 * (1.0 / 6227020800.0 + r2 * (-1.0 / 1307674368000.0))))))));
#pragma unroll 1
    for (int i = 0; i < 3; ++i) { const double s2 = 2.0 * s * c, c2 = 1.0 - 2.0 * s * s; s = s2; c = c2; }
    sn = s; cs = c;
}

namespace pg8 {
constexpr int BM = 256, BK = 64, HALF = 128, HTB = HALF * BK * 2, STAGE_BYTES = 8 * HTB, NXCD = 8, WGM = 8;
__device__ __forceinline__ int lds_byte(int r, int c) { const int st = (r >> 4) * 2 + (c >> 5), rr = r & 15, cc = c & 31, ob = rr * 64 + cc * 2; return st * 1024 + (ob ^ (((ob >> 9) & 1) << 5)); }
__device__ __forceinline__ void stage_rc(int b, int& R, int& C) { const int st = b / 1024, sb = b % 1024, swz = sb ^ (((sb >> 9) & 1) << 5); R = (st >> 1) * 16 + swz / 64; C = (st & 1) * 32 + (swz % 64) / 2; }
__device__ __forceinline__ int perm32(int rho) { const int n = rho >> 4, i = rho & 15; return 8 * (i >> 2) + 4 * n + (i & 3); }

struct Unit { int pm, pn, g, kh, half; size_t offA, offB; };
struct Operand { const char* base; size_t kstep, hstep; };
struct RowMajorOff { int K; __device__ __forceinline__ unsigned operator()(int R, int C) const { return (unsigned)(R * K + C) * 2u; } };
struct UStrideOff { __device__ __forceinline__ unsigned operator()(int R, int C) const { return (unsigned)(((R * CT + (C >> 4)) * D_SSM + (C & 15)) * 2); } };

struct RectOrder {
    int nM, nN, nwg, G, c; size_t tA, tB;
    __device__ __forceinline__ void init(int Mr, int Nr, int G_, int c_, size_t tA_, size_t tB_) { nM = Mr / BM; nN = Nr / BM; nwg = nM * nN; G = G_; c = c_; tA = tA_; tB = tB_; }
    __device__ __forceinline__ bool next(int i, Unit& u) const {
        const long L = (long)i * G + c; if (L >= nwg) return false;
        int wgid = (int)L; { const int q = nwg / NXCD, r = nwg % NXCD, xcd = wgid % NXCD, off = wgid / NXCD; wgid = (xcd < r ? xcd * (q + 1) : r * (q + 1) + (xcd - r) * q) + off; }
        const int nig = WGM * nN, gid = wgid / nig, fm = gid * WGM, gsz = (nM - fm) < WGM ? (nM - fm) : WGM;
        u.pm = fm + ((wgid % nig) % gsz); u.pn = (wgid % nig) / gsz; u.g = 0; u.kh = 1; u.half = 0; u.offA = (size_t)u.pm * tA; u.offB = (size_t)u.pn * tB; return true;
    }
};
struct RectOrderK2 { RectOrder base; size_t khalf_bytes;
    __device__ __forceinline__ bool next(int i, Unit& u) const { if (!base.next(i >> 1, u)) return false; u.kh = i & 1; if (u.kh) { u.offA += khalf_bytes; u.offB += khalf_bytes; } return true; } };
struct RangeOrder { int nM, pn0, first, cnt; size_t tA, tB;
    __device__ __forceinline__ bool next(int i, Unit& u) const { if (i >= cnt) return false; const int L = first + i; u.pm = L % nM; u.pn = pn0 + L / nM; u.g = 0; u.kh = 1; u.half = 0; u.offA = (size_t)u.pm * tA; u.offB = (size_t)(L / nM) * tB; return true; } };
struct OneUnit2 { int id; size_t tA, tB, gA, gB;
    __device__ __forceinline__ bool next(int i, Unit& u) const { if (i > 0) return false; const int g = id >> 2, r = id & 3; u.g = g; u.kh = 1; u.half = 0; u.pm = r & 1; u.pn = r >> 1;
        u.offA = (size_t)g * gA + (size_t)u.pm * tA; u.offB = (size_t)g * gB + (size_t)u.pn * tB; return true; } };
struct GroupOrder {
    int nM, nN, ng, G, c; size_t tA, tB, gA, gB;
    __device__ __forceinline__ bool next(int i, Unit& u) const {
        const long L = (long)i * G + c; if (L >= (long)ng * nM * nN) return false;
        int g, pm, pn;
        if (nN == 3) {
            const int nfull = ng * nM * 2;
            if (L < nfull) { g = (int)(L / (nM * 2)); const int r = (int)(L % (nM * 2)); pm = r % nM; pn = r / nM; } else { const int e = (int)(L - nfull); g = e / nM; pm = e % nM; pn = 2; }
        } else { const int per = nM * nN; g = (int)(L / per); const int r = (int)(L % per); pm = r % nM; pn = r / nM; }
        u.g = g; u.kh = 1; u.half = (nN == 3 && pn == 2) ? 1 : 0; u.pm = pm; u.pn = pn; u.offA = (size_t)g * gA + (size_t)pm * tA; u.offB = (size_t)g * gB + (size_t)pn * tB; return true;
    }
};

template <bool MID = false, bool I8 = false, bool WIDE = false, bool HALFN = false, class Epi, class Sched, class AOff, class BOff>
__device__ __forceinline__ void gemm_phase(LAS unsigned char* lds, const Operand opA, const Operand opB, const int nt, const AOff aoffF, const BOff boffF, const Sched& S, const Epi& E) {
    const int tid = threadIdx.x, wid = __builtin_amdgcn_readfirstlane(tid >> 6), lane = tid & 63, wr = wid >> 2, wc = wid & 3, fr = lane & 15, fq = lane >> 4;
    unsigned voffA[2], voffB[2];
#pragma unroll
    for (int i = 0; i < 2; ++i) { int R, C; stage_rc(tid * 16 + i * 8192, R, C); const int Rb = (R & ~31) + perm32(R & 31);
        voffA[i] = aoffF(R, C); voffB[i] = boffF(WIDE ? 16 * (Rb >> 3) + (Rb & 7) : Rb, C); }
    const size_t kA = opA.kstep, hA = opA.hstep, kB = opB.kstep, hB = opB.hstep;
    const unsigned ldsw = (unsigned)wid * 1024u;
    const int aoff = lds_byte(wr * 64 + fr, fq * 8), boff = lds_byte(wc * 32 + fr, fq * 8);
#define PG8_SA(b, h) (((b) * 2 + (h)) * HTB)
#define PG8_SB(b, h) ((4 + (b) * 2 + (h)) * HTB)
#define PG8_STAGE(bufoff, gbase, voff) do { _Pragma("unroll") for (int _i = 0; _i < 2; ++_i) \
        __builtin_amdgcn_global_load_lds((const unsigned*)((const char*)(gbase) + (voff)[_i]), (LAS unsigned*)(lds + (bufoff) + ldsw + _i * 8192), 16, 0, 0); } while (0)
#define PG8_LDA(dst, b, h) do { _Pragma("unroll") for (int m = 0; m < 4; ++m) _Pragma("unroll") for (int k = 0; k < 2; ++k) dst[m][k] = *(const LAS half8*)(lds + PG8_SA(b, h) + aoff + m * 2048 + k * 1024); } while (0)
#define PG8_LDB(dst, b, h) do { _Pragma("unroll") for (int n = 0; n < 2; ++n) _Pragma("unroll") for (int k = 0; k < 2; ++k) dst[n][k] = *(const LAS half8*)(lds + PG8_SB(b, h) + boff + n * 2048 + k * 1024); } while (0)
#define PG8_MMA(ai, bj, At, Bt) do { __builtin_amdgcn_s_setprio(1); _Pragma("unroll") for (int m = 0; m < 4; ++m) _Pragma("unroll") for (int n = 0; n < 2; ++n) _Pragma("unroll") for (int k = 0; k < 2; ++k) { \
        if constexpr (I8) acc[ai][bj][m][n] = __builtin_bit_cast(f32x4, __builtin_amdgcn_mfma_i32_16x16x64_i8(__builtin_bit_cast(i32x4, Bt[n][k]), __builtin_bit_cast(i32x4, At[m][k]), __builtin_bit_cast(i32x4, acc[ai][bj][m][n]), 0, 0, 0)); \
        else acc[ai][bj][m][n] = __builtin_amdgcn_mfma_f32_16x16x32_f16(Bt[n][k], At[m][k], acc[ai][bj][m][n], 0, 0, 0); } __builtin_amdgcn_s_setprio(0); } while (0)
#define PG8_WAIT_V(n) asm volatile("s_waitcnt vmcnt(" #n ")" ::: "memory")
#define PG8_WAIT_L(n) asm volatile("s_waitcnt lgkmcnt(" #n ")" ::: "memory")
#define PG8_BAR __builtin_amdgcn_s_barrier()
#define PG8_SCHED __builtin_amdgcn_sched_barrier(0)
    Unit cur, nxt; int ui = 0;
    if (!S.next(0, cur)) return;
    f32x4 acc[2][2][4][2];
#pragma unroll
    for (int a = 0; a < 2; ++a)
#pragma unroll
        for (int b = 0; b < 2; ++b)
#pragma unroll
            for (int m = 0; m < 4; ++m)
#pragma unroll
                for (int n = 0; n < 2; ++n) acc[a][b][m][n] = (f32x4){0.f, 0.f, 0.f, 0.f};
    half8 At[4][2], B0[2][2], B1[2][2];
    const char* cA = opA.base + cur.offA; const char* cB = opB.base + cur.offB;
    PG8_STAGE(PG8_SB(0, 0), cB, voffB); PG8_STAGE(PG8_SB(0, 1), cB + hB, voffB); PG8_STAGE(PG8_SA(0, 0), cA, voffA); PG8_STAGE(PG8_SA(0, 1), cA + hA, voffA);
    if (wr == 1) PG8_BAR;
    PG8_WAIT_V(2); PG8_BAR;
    PG8_STAGE(PG8_SB(1, 0), cB + kB, voffB); PG8_STAGE(PG8_SA(1, 0), cA + kA, voffA); PG8_STAGE(PG8_SB(1, 1), cB + hB + kB, voffB);
    PG8_WAIT_V(6); PG8_BAR;
    for (;;) {
        const bool has_next = S.next(ui + 1, nxt);
        const char* nA = has_next ? opA.base + nxt.offA : cA; const char* nB = has_next ? opB.base + nxt.offB : cB;
        for (int t = 0; t < nt; t += 2) {
            const bool last = (t == nt - 2);
            const char* a1 = cA + (size_t)(t + 1) * kA;
            const char* a2 = last ? nA : cA + (size_t)(t + 2) * kA; const char* b2 = last ? nB : cB + (size_t)(t + 2) * kB;
            const char* a3 = a2 + kA; const char* b3 = b2 + kB;
            PG8_LDB(B0, 0, 0); PG8_LDB(B1, 0, 1); PG8_SCHED; PG8_LDA(At, 0, 0); PG8_STAGE(PG8_SA(1, 1), a1 + hA, voffA);
            PG8_WAIT_V(8); PG8_WAIT_L(0); PG8_BAR; PG8_MMA(0, 0, At, B0); if (!HALFN || !cur.half) PG8_MMA(0, 1, At, B1); PG8_BAR; PG8_SCHED;
            PG8_LDA(At, 0, 1); PG8_STAGE(PG8_SB(0, 0), b2, voffB); PG8_STAGE(PG8_SB(0, 1), b2 + hB, voffB); PG8_STAGE(PG8_SA(0, 0), a2, voffA);
            PG8_WAIT_V(8); PG8_WAIT_L(0); PG8_BAR; PG8_MMA(1, 0, At, B0); if (!HALFN || !cur.half) PG8_MMA(1, 1, At, B1); PG8_BAR; PG8_SCHED;
            PG8_LDB(B0, 1, 0); PG8_LDB(B1, 1, 1); PG8_SCHED; PG8_LDA(At, 1, 0); PG8_STAGE(PG8_SA(0, 1), a2 + hA, voffA);
            PG8_WAIT_V(8); PG8_WAIT_L(0); PG8_BAR; PG8_MMA(0, 0, At, B0); if (!HALFN || !cur.half) PG8_MMA(0, 1, At, B1); PG8_BAR; PG8_SCHED;
            PG8_LDA(At, 1, 1); PG8_STAGE(PG8_SB(1, 0), b3, voffB); PG8_STAGE(PG8_SB(1, 1), b3 + hB, voffB); PG8_STAGE(PG8_SA(1, 0), a3, voffA);
            PG8_WAIT_V(8); PG8_WAIT_L(0); PG8_BAR; PG8_MMA(1, 0, At, B0); if (!HALFN || !cur.half) PG8_MMA(1, 1, At, B1); PG8_BAR; PG8_SCHED;
        }
        if (wr == 0) PG8_BAR;
        bool carry = false;
        if constexpr (MID) { if (cur.kh == 0) { E.mid(acc, cur, wr, wc, fr, fq); carry = true; } }
        if (!carry) E(acc, cur, wr, wc, fr, fq);
        if (!has_next) break;
        if (!carry) {
#pragma unroll
        for (int a = 0; a < 2; ++a)
#pragma unroll
            for (int b = 0; b < 2; ++b)
#pragma unroll
                for (int m = 0; m < 4; ++m)
#pragma unroll
                    for (int n = 0; n < 2; ++n) acc[a][b][m][n] = (f32x4){0.f, 0.f, 0.f, 0.f}; }
        cur = nxt; cA = nA; cB = nB; ++ui;
        if (wr == 1) PG8_BAR;
    }
    PG8_WAIT_V(0);
    PG8_BAR;
#undef PG8_SA
#undef PG8_SB
#undef PG8_STAGE
#undef PG8_LDA
#undef PG8_LDB
#undef PG8_MMA
#undef PG8_WAIT_V
#undef PG8_WAIT_L
#undef PG8_BAR
#undef PG8_SCHED
}

#define EPI_ROWS(ai, m) for (int ai = 0; ai < 2; ++ai) _Pragma("unroll") for (int m = 0; m < 4; ++m)
struct EpiProj {
    f16 *U16, *Q16, *K16, *V16; float *QI32, *KW32; float sc8;
    __device__ __forceinline__ void operator()(const f32x4 (&acc)[2][2][4][2], const Unit& u, int wr, int wc, int fr, int fq) const {
        const int pn = u.pn; const int row0 = u.pm * BM + wr * 64 + fr, cl = wc * 32 + 8 * fq;
        if (pn < 10) {
            f16* base; int pitch, c0;
            if (pn < 4) { base = U16; pitch = 1024; c0 = pn * 256; } else if (pn < 8) { base = Q16; pitch = 1024; c0 = (pn - 4) * 256; } else if (pn == 8) { base = K16; pitch = 256; c0 = 0; } else { base = V16; pitch = 256; c0 = 0; }
#pragma unroll
            EPI_ROWS(ai, m) { f16* rowp = base + (size_t)(row0 + ai * HALF + m * 16) * pitch + c0 + cl;
#pragma unroll
                for (int bj = 0; bj < 2; ++bj) { f32x4 v0 = acc[ai][bj][m][0] * WSC_INV, v1 = acc[ai][bj][m][1] * WSC_INV;
                    if (sc8 != 0.f) { const i32x4 a0 = __builtin_bit_cast(i32x4, acc[ai][bj][m][0]), a1 = __builtin_bit_cast(i32x4, acc[ai][bj][m][1]);
                        v0 = (f32x4){(float)a0[0], (float)a0[1], (float)a0[2], (float)a0[3]} * sc8; v1 = (f32x4){(float)a1[0], (float)a1[1], (float)a1[2], (float)a1[3]} * sc8; }
                    *(u32x4*)(rowp + bj * HALF) = pk8(v0, v1); } }
        } else {
            float* base; int pitch, c0;
            if (pn < 14) { base = QI32; pitch = 1024; c0 = (pn - 10) * 256; } else { base = KW32; pitch = 256; c0 = 0; }
#pragma unroll
            EPI_ROWS(ai, m) { float* rowp = base + (size_t)(row0 + ai * HALF + m * 16) * pitch + c0 + cl;
#pragma unroll
                for (int bj = 0; bj < 2; ++bj) { *(f32x4*)(rowp + bj * HALF) = acc[ai][bj][m][0] * WSC_INV; *(f32x4*)(rowp + bj * HALF + 4) = acc[ai][bj][m][1] * WSC_INV; } }
        }
    }
};
struct EpiSsm1 {
    f16* YIN; float* E32;
    __device__ __forceinline__ void operator()(const f32x4 (&acc)[2][2][4][2], const Unit& u, int wr, int wc, int fr, int fq) const {
        const int R0 = u.pm * BM + wr * 64 + fr, cl = wc * 32 + 8 * fq;
        if (u.pn < 2) {
#pragma unroll
            EPI_ROWS(ai, m) { const int R = R0 + ai * HALF + m * 16;
#pragma unroll
                for (int bj = 0; bj < 2; ++bj) { const int n = u.pn * 256 + bj * HALF + cl; const int t = n >> 4, h0 = n & 15;
                    *(u32x4*)(YIN + (size_t)(R * CT + t) * D_SSM + u.g * SG + h0) = pk8(acc[ai][bj][m][0] * TSC_INV, acc[ai][bj][m][1] * TSC_INV); } }
        } else {
#pragma unroll
            EPI_ROWS(ai, m) { const int R = R0 + ai * HALF + m * 16; float* rowp = E32 + ((size_t)u.g * 512 + R) * 128 + cl;
                *(f32x4*)(rowp) = acc[ai][0][m][0] * TSC_INV; *(f32x4*)(rowp + 4) = acc[ai][0][m][1] * TSC_INV; }
        }
    }
};
struct EpiSsm2 {
    f16* YIN; const f16* U16; const float* dskip;
    __device__ __forceinline__ void operator()(const f32x4 (&acc)[2][2][4][2], const Unit& u, int wr, int wc, int fr, int fq) const {
        const int R0 = u.pm * BM + wr * 64 + fr, cl = wc * 32 + 8 * fq; const int n0 = u.pn * 256 + cl, h0 = n0 & 15;
        const f32x4 d0 = *(const f32x4*)(dskip + u.g * SG + h0), d1 = *(const f32x4*)(dskip + u.g * SG + h0 + 4);
        unsigned off = (unsigned)((R0 * CT + (n0 >> 4)) * D_SSM + u.g * SG + h0);
#pragma unroll
        EPI_ROWS(ai, m) {
#pragma unroll
            for (int bj = 0; bj < 2; ++bj) { asm volatile("" : "+v"(off));
                const unsigned o2 = off + (unsigned)(bj * 8 * D_SSM);
                float yi[8], uu[8]; unpk8(*(const u32x4*)(YIN + o2), yi); unpk8(*(const u32x4*)(U16 + o2), uu);
                f32x4 o0, o1;
#pragma unroll
                for (int j = 0; j < 4; ++j) { o0[j] = gelu_tanh(acc[ai][bj][m][0][j] * WSC_INV + yi[j] + d0[j] * uu[j]); o1[j] = gelu_tanh(acc[ai][bj][m][1][j] * WSC_INV + yi[4 + j] + d1[j] * uu[4 + j]); }
                *(u32x4*)(YIN + o2) = pk8(o0, o1);
                asm volatile("" ::: "memory"); }
            off += (unsigned)((m == 3 ? (HALF - 48) : 16) * CT * D_SSM); }
    }
};
struct EpiGlu {
    const f16* YA; f16* MIX; const float* bglu; float* rss;
    __device__ __forceinline__ void operator()(const f32x4 (&acc)[2][2][4][2], const Unit& u, int wr, int wc, int fr, int fq) const {
        const int row0 = u.pm * BM + wr * 64 + fr, c0 = u.pn * BM + wc * 32 + 8 * fq;
#pragma unroll
        EPI_ROWS(ai, m) { const int r = row0 + ai * HALF + m * 16; float ss = 0.f;
#pragma unroll
            for (int bj = 0; bj < 2; ++bj) { const int c = c0 + bj * HALF; float ya[8]; unpk8(*(const u32x4*)(YA + (size_t)r * D_SSM + c), ya);
                const f32x4 b0 = *(const f32x4*)(bglu + c), b1 = *(const f32x4*)(bglu + c + 4); f32x4 o0, o1;
#pragma unroll
                for (int j = 0; j < 4; ++j) { o0[j] = ya[j] * sigmoidf_(acc[ai][bj][m][0][j] * WSC_INV + b0[j]); o1[j] = ya[4 + j] * sigmoidf_(acc[ai][bj][m][1][j] * WSC_INV + b1[j]); ss += o0[j] * o0[j] + o1[j] * o1[j]; }
                *(u32x4*)(MIX + (size_t)r * D + c) = pk8(o0, o1); }
            ss += __shfl_xor(ss, 16); ss += __shfl_xor(ss, 32);
            if (fq == 0) unsafeAtomicAdd(rss + r, ss);
            asm volatile("" ::: "memory"); }
    }
};
struct EpiOut {
    const float* x; f16* out; f16* X16; const float* vec; float* rsx; const float* rss; const float* rsa2;
    __device__ __forceinline__ float r_s(int r) const { return __builtin_amdgcn_rsqf(rss[r] * (1.0f / D_SSM) + EPS); }
    __device__ __forceinline__ float r_a(int r) const { return __builtin_amdgcn_rsqf((rsa2[2 * r] + rsa2[2 * r + 1]) * (1.0f / D_ATTN) + EPS); }
    __device__ __forceinline__ void mid(f32x4 (&acc)[2][2][4][2], const Unit& u, int wr, int wc, int fr, int fq) const {
        const int row0 = u.pm * BM + wr * 64 + fr;
#pragma unroll
        EPI_ROWS(ai, m) { const int r = row0 + ai * HALF + m * 16;
            const float f = __builtin_amdgcn_rsqf(rss[r] * (1.0f / D_SSM) + EPS) * __builtin_amdgcn_sqrtf((rsa2[2 * r] + rsa2[2 * r + 1]) * (1.0f / D_ATTN) + EPS);
#pragma unroll
            for (int bj = 0; bj < 2; ++bj)
#pragma unroll
                for (int n = 0; n < 2; ++n) acc[ai][bj][m][n] *= f;
            asm volatile("" ::: "memory"); }
    }
    __device__ __forceinline__ void operator()(const f32x4 (&acc)[2][2][4][2], const Unit& u, int wr, int wc, int fr, int fq) const {
        const int row0 = u.pm * BM + wr * 64 + fr, c0 = u.pn * BM + wc * 32 + 8 * fq; const float* vb = vec + (u.pm >= 32 ? 6 * D : 0);
#pragma unroll
        EPI_ROWS(ai, m) { const int r = row0 + ai * HALF + m * 16; float ss = 0.f; const float ra = r_a(r) * WSC_INV;
#pragma unroll
            for (int bj = 0; bj < 2; ++bj) { const int c = c0 + bj * HALF; const size_t off = (size_t)r * D + c;
                f32x4 x1[2]; u32x2 q8;
#pragma unroll
                for (int n = 0; n < 2; ++n) { const f32x4 xv = *(const f32x4*)(x + off + 4 * n), ga = *(const f32x4*)(vb + 0 * D + c + 4 * n);
                    x1[n] = xv + ga * (acc[ai][bj][m][n] * ra); ss += x1[n][0] * x1[n][0] + x1[n][1] * x1[n][1] + x1[n][2] * x1[n][2] + x1[n][3] * x1[n][3];
                    const f32x4 cs = *(const f32x4*)(vb + 1 * D + c + 4 * n); const f32x4 xs = x1[n] * cs; const unsigned q = pk4i8(xs[0], xs[1], xs[2], xs[3], XA8_S); if (n == 0) q8.x = q; else q8.y = q; }
                *(u32x4*)(out + off) = pk8(x1[0], x1[1]);
                *(u32x2*)((char*)X16 + off) = q8; }
            ss += __shfl_xor(ss, 16); ss += __shfl_xor(ss, 32);
            if (fq == 0) unsafeAtomicAdd(rsx + r, ss);
            asm volatile("" ::: "memory"); }
    }
};
constexpr float SQH = 3.2596012026f;
struct EpiUp {
    f16* HFF; const float* bias2; const float* rsx;
    __device__ __forceinline__ void operator()(const f32x4 (&acc)[2][2][4][2], const Unit& u, int wr, int wc, int fr, int fq) const {
        const int row0 = u.pm * BM + wr * 64 + fr, c0 = u.pn * BM + wc * 64 + 16 * fq; const float* bb = bias2 + (u.pm >= 32 ? D_FF : 0);
        f32x4 bv[2][2];
#pragma unroll
        for (int bj = 0; bj < 2; ++bj)
#pragma unroll
            for (int n = 0; n < 2; ++n) bv[bj][n] = *(const f32x4*)(bb + c0 + 8 * bj + 4 * n) * SQH;
#pragma unroll
        EPI_ROWS(ai, m) { const int r = row0 + ai * HALF + m * 16; const float rs = __builtin_amdgcn_rsqf(rsx[r] * (1.0f / D) + EPS) * (SQH / (XA8_S * WU8_S)); u32x4 w;
#pragma unroll
            for (int bj = 0; bj < 2; ++bj) { const i32x4 a0 = __builtin_bit_cast(i32x4, acc[ai][bj][m][0]), a1 = __builtin_bit_cast(i32x4, acc[ai][bj][m][1]);
                f32x4 v0 = (f32x4){(float)a0[0], (float)a0[1], (float)a0[2], (float)a0[3]} * rs + bv[bj][0], v1 = (f32x4){(float)a1[0], (float)a1[1], (float)a1[2], (float)a1[3]} * rs + bv[bj][1];
#pragma unroll
                for (int j = 0; j < 4; ++j) { v0[j] = fmaxf(v0[j], 0.f); v1[j] = fmaxf(v1[j], 0.f); }
                v0 = v0 * v0; v1 = v1 * v1;
                const unsigned q0 = pk4u8m128(v0[0], v0[1], v0[2], v0[3], 1.0f), q1 = pk4u8m128(v1[0], v1[1], v1[2], v1[3], 1.0f);
                if (bj == 0) { w.x = q0; w.y = q1; } else { w.z = q0; w.w = q1; } }
            *(u32x4*)((char*)HFF + (size_t)r * D_FF + c0) = w; }
    }
};
struct EpiDown {
    float* out; const f16* x1h; const float* vec; const float* csum;
    __device__ __forceinline__ void operator()(const f32x4 (&acc)[2][2][4][2], const Unit& u, int wr, int wc, int fr, int fq) const {
        const int row0 = u.pm * BM + wr * 64 + fr, c0 = u.pn * BM + wc * 32 + 8 * fq; const float* vb = vec + (u.pm >= 32 ? 6 * D : 0);
        f32x4 gm[2][2];
#pragma unroll
        for (int bj = 0; bj < 2; ++bj)
#pragma unroll
            for (int n = 0; n < 2; ++n) gm[bj][n] = *(const f32x4*)(vb + 3 * D + c0 + bj * HALF + 4 * n) * (1.0f / (H8_S * WD8_S));
        f32x4 cs4[2][2];
#pragma unroll
        for (int bj = 0; bj < 2; ++bj)
#pragma unroll
            for (int n = 0; n < 2; ++n) cs4[bj][n] = *(const f32x4*)(csum + c0 + bj * HALF + 4 * n) * 128.0f;
#pragma unroll
        EPI_ROWS(ai, m) { const int r = row0 + ai * HALF + m * 16;
#pragma unroll
            for (int bj = 0; bj < 2; ++bj)
            { const size_t off = (size_t)r * D + c0 + bj * HALF; float xh[8]; unpk8(*(const u32x4*)(x1h + off), xh);
#pragma unroll
                for (int n = 0; n < 2; ++n) { const i32x4 ai4 = __builtin_bit_cast(i32x4, acc[ai][bj][m][n]);
                    *(f32x4*)(out + off + 4 * n) = (f32x4){xh[4 * n], xh[4 * n + 1], xh[4 * n + 2], xh[4 * n + 3]} + gm[bj][n] * ((f32x4){(float)ai4[0], (float)ai4[1], (float)ai4[2], (float)ai4[3]} + cs4[bj][n]); } } }
    }
};
struct EpiDry { float* sink;
    __device__ __forceinline__ void operator()(const f32x4 (&acc)[2][2][4][2], const Unit& u, int wr, int wc, int fr, int fq) const {
        float s = 0.f;
#pragma unroll
        for (int ai = 0; ai < 2; ++ai)
#pragma unroll
            for (int bj = 0; bj < 2; ++bj)
#pragma unroll
                for (int m = 0; m < 4; ++m)
#pragma unroll
                    for (int n = 0; n < 2; ++n) s += acc[ai][bj][m][n][0] + acc[ai][bj][m][n][3];
        if (s == 123456.789f) sink[u.pm] = s; } };
}

struct Args {
    const float* in[25]; float* out; unsigned char* ws;
    double inv16[16]; double inv8[8];
    int ph_lo, ph_hi;
};
constexpr int NWAVES = 8, NPH = 11;

struct Frame {
    LAS unsigned char* lds; int tid, lane, wave, G, bx, gw, NGW;
    unsigned char* ws;
};

__device__ __forceinline__ void p0_transpose_item(const float* W, int K, int N, f16* WT, LAS float* scr, int item, int nblk, int lane, const float* g0 = nullptr, const float* g1 = nullptr) {
    const int kb = item / nblk, nb = item % nblk, k0 = 64 * kb, n0 = 32 * nb; const int nn = n0 + (lane & 31);
    float tv[32];
#pragma unroll
    for (int i = 0; i < 32; ++i) { const int kk = 2 * i + (lane >> 5); tv[i] = nn < N ? W[(size_t)(k0 + kk) * N + nn] : 0.f; }
#pragma unroll
    for (int i = 0; i < 32; ++i) { const int kk = 2 * i + (lane >> 5); float gg = 1.0f; if (g0) { const int k = k0 + kk; gg = k < 1024 ? g0[k] : g1[k - 1024]; } scr[kk * 33 + (lane & 31)] = tv[i] * gg; }
    LDS_WAIT(); asm volatile("" ::: "memory");
    const int c = lane & 7;
#pragma unroll
    for (int j = 0; j < 4; ++j) { const int n = (lane >> 3) + 8 * j; const LAS float* s = scr + (8 * c) * 33 + n;
        u32x4 o; o.x = pkh(s[0 * 33] * WSC, s[1 * 33] * WSC); o.y = pkh(s[2 * 33] * WSC, s[3 * 33] * WSC); o.z = pkh(s[4 * 33] * WSC, s[5 * 33] * WSC); o.w = pkh(s[6 * 33] * WSC, s[7 * 33] * WSC);
        *(GAS u32x4*)(WT + (size_t)(n0 + n) * K + k0 + 8 * c) = o; }
    LDS_WAIT(); asm volatile("" ::: "memory");
}
__device__ __forceinline__ void p0_transpose_item_i8(const float* W, int K, int N, signed char* WT, LAS float* scr, int item, int nblk, int lane, const float SC) {
    const int kb = item / nblk, nb = item % nblk, k0 = 64 * kb, n0 = 32 * nb; const int nn = n0 + (lane & 31);
    float tv[32];
#pragma unroll
    for (int i = 0; i < 32; ++i) { const int kk = 2 * i + (lane >> 5); tv[i] = W[(size_t)(k0 + kk) * N + nn]; }
#pragma unroll
    for (int i = 0; i < 32; ++i) { const int kk = 2 * i + (lane >> 5); scr[kk * 33 + (lane & 31)] = tv[i]; }
    LDS_WAIT(); asm volatile("" ::: "memory");
    const int c = lane & 3;
#pragma unroll
    for (int j = 0; j < 2; ++j) { const int n = (lane >> 2) + 16 * j; const LAS float* s = scr + (16 * c) * 33 + n;
        u32x4 o; o.x = pk4i8(s[0 * 33], s[1 * 33], s[2 * 33], s[3 * 33], SC); o.y = pk4i8(s[4 * 33], s[5 * 33], s[6 * 33], s[7 * 33], SC); o.z = pk4i8(s[8 * 33], s[9 * 33], s[10 * 33], s[11 * 33], SC); o.w = pk4i8(s[12 * 33], s[13 * 33], s[14 * 33], s[15 * 33], SC);
        *(GAS u32x4*)(WT + (size_t)(n0 + n) * K + k0 + 16 * c) = o; }
    LDS_WAIT(); asm volatile("" ::: "memory");
}
__device__ __forceinline__ void p0_tables(const Frame& F, const Args& a, int g) {
    LAS float* pwr = (LAS float*)F.lds; LAS float* pwi = pwr + 33 * 64; LAS float* Bbr = pwi + 33 * 64; LAS float* Bbi = Bbr + 1024; LAS float* Ccr = Bbi + 1024; LAS float* Cci = Ccr + 1024; LAS float* Kd = Cci + 1024;
    const float *lam_re = a.in[7], *lam_im = a.in[8], *log_dt = a.in[9], *b_re = a.in[10], *b_im = a.in[11], *c_re = a.in[12], *c_im = a.in[13];
    float* lamT = (float*)(F.ws + WS_SMALL) + SM_LAMT;
    if (F.tid < 64) {
        const int p = F.tid; const double dt = dexp((double)log_dt[g]); const double lr = (double)fminf(lam_re[g * SP + p], -1e-4f), li = (double)lam_im[g * SP + p];
        const double mag = dexp(lr * dt); double sn, cs; dsincos(li * dt, sn, cs); const double ar = mag * cs, ai = mag * sn;
        const double den = lr * lr + li * li; const double fr_ = ((ar - 1.0) * lr + ai * li) / den, fi_ = (ai * lr - (ar - 1.0) * li) / den;
        double pr = 1.0, pi = 0.0;
#pragma unroll 1
        for (int d = 0; d <= 32; ++d) { pwr[d * 64 + p] = (float)pr; pwi[d * 64 + p] = (float)pi; const double nr = pr * ar - pi * ai, ni = pr * ai + pi * ar; pr = nr; pi = ni; }
        lamT[(g * 64 + p) * 2 + 0] = pwr[32 * 64 + p]; lamT[(g * 64 + p) * 2 + 1] = pwi[32 * 64 + p];
#pragma unroll 1
        for (int h = 0; h < 16; ++h) { const double br = (double)b_re[(g * SP + p) * SG + h], bi = (double)b_im[(g * SP + p) * SG + h]; Bbr[p * 16 + h] = (float)(fr_ * br - fi_ * bi); Bbi[p * 16 + h] = (float)(fr_ * bi + fi_ * br); }
    }
    for (int i = F.tid; i < 1024; i += 512) { Ccr[i] = c_re[g * 1024 + i]; Cci[i] = c_im[g * 1024 + i]; }
    __syncthreads();
    {
        const int pr = F.tid & 255, h = pr >> 4, hp = pr & 15, dh = (F.tid >> 8) * 16; float kacc[16];
#pragma unroll
        for (int dd = 0; dd < 16; ++dd) kacc[dd] = 0.f;
#pragma unroll 2
        for (int p = 0; p < 64; ++p) { const float cr = Ccr[h * 64 + p], ci_ = Cci[h * 64 + p], br = Bbr[p * 16 + hp], bi = Bbi[p * 16 + hp]; const float zr = cr * br - ci_ * bi, zi = cr * bi + ci_ * br;
#pragma unroll
            for (int dd = 0; dd < 16; ++dd) kacc[dd] += zr * pwr[(dh + dd) * 64 + p] - zi * pwi[(dh + dd) * 64 + p]; }
#pragma unroll
        for (int dd = 0; dd < 16; ++dd) Kd[((dh + dd) * 16 + h) * 16 + hp] = kacc[dd];
    }
    __syncthreads();
    f16* T1 = (f16*)(F.ws + WS_T1) + (size_t)g * 768 * 512;
    for (int q = F.tid; q < 768 * 64; q += 512) { const int n = q >> 6, kc = q & 63, j = kc >> 1, h0 = (kc & 1) * 8; float v[8];
        if (n < 512) { const int t = n >> 4, h = n & 15;
#pragma unroll
            for (int e = 0; e < 8; ++e) v[e] = (j <= t) ? Kd[((t - j) * 16 + h) * 16 + h0 + e] * TSC : 0.f;
        } else if (n < 640) { const int e_ = n - 512, p = e_ & 63, part = e_ >> 6, d = 31 - j; const float lr_ = pwr[d * 64 + p], li_ = pwi[d * 64 + p];
#pragma unroll
            for (int e = 0; e < 8; ++e) { const float br = Bbr[p * 16 + h0 + e], bi = Bbi[p * 16 + h0 + e]; v[e] = (part == 0 ? (lr_ * br - li_ * bi) : (lr_ * bi + li_ * br)) * TSC; }
        } else {
#pragma unroll
            for (int e = 0; e < 8; ++e) v[e] = 0.f; }
        u32x4 o; o.x = pkh(v[0], v[1]); o.y = pkh(v[2], v[3]); o.z = pkh(v[4], v[5]); o.w = pkh(v[6], v[7]);
        *(GAS u32x4*)(T1 + (size_t)n * 512 + kc * 8) = o; }
    f16* WY = (f16*)(F.ws + WS_WY) + (size_t)g * 512 * 256;
    for (int q = F.tid; q < 512 * 32; q += 512) { const int n = q >> 5, kc = q & 31, t = n >> 4, h = n & 15; float v[8];
#pragma unroll
        for (int e = 0; e < 8; ++e) { const int k = kc * 8 + e;
            if (k < 64) { v[e] = (Ccr[h * 64 + k] * pwr[(t + 1) * 64 + k] - Cci[h * 64 + k] * pwi[(t + 1) * 64 + k]) * WSC; }
            else if (k < 128) { const int p = k - 64; v[e] = -(Ccr[h * 64 + p] * pwi[(t + 1) * 64 + p] + Cci[h * 64 + p] * pwr[(t + 1) * 64 + p]) * WSC; }
            else v[e] = 0.f; }
        u32x4 o; o.x = pkh(v[0], v[1]); o.y = pkh(v[2], v[3]); o.z = pkh(v[4], v[5]); o.w = pkh(v[6], v[7]);
        *(GAS u32x4*)(WY + (size_t)n * 256 + kc * 8) = o; }
    __syncthreads();
}
struct CvItem { const float* W; unsigned char* WT; const float* g0; const float* g1; int N, K, k0, n0, i8; float sc; };
constexpr int CV_IN8 = (D / 64) * 10, CV_IN = (D / 64) * 5, CV_GLU = (D_SSM / 64) * (D_SSM / 256), CV_OUT = (D / 64) * (D / 256), CV_UP = (D / 64) * (D_FF / 256), CV_DN = (D_FF / 64) * (D / 256);
constexpr int CV_NITEMS = CV_IN8 + CV_IN + CV_GLU + CV_OUT + CV_UP + CV_DN;
struct CvSrc { const float *w_in, *w_glu, *w_out, *w_up, *w_dn, *g_s, *g_a; };
__device__ __forceinline__ CvItem cv_decode(const CvSrc& a, unsigned char* ws, int r) {
    CvItem c; c.g0 = nullptr; c.g1 = nullptr;
    if (r < CV_IN8) { c.W = a.w_in; c.WT = ws + WS_WIN8; c.N = D_IN; c.K = D; c.k0 = 64 * (r / 10); c.n0 = 256 * (r % 10); c.i8 = 1; c.sc = WU8_S; return c; } r -= CV_IN8;
    if (r < CV_IN) { c.W = a.w_in; c.WT = ws + WS_WIN; c.N = D_IN; c.K = D; c.k0 = 64 * (r / 5); c.n0 = 2560 + 256 * (r % 5); c.i8 = 0; c.sc = WSC; return c; } r -= CV_IN;
    if (r < CV_GLU) { c.W = a.w_glu; c.WT = ws + WS_WGLU; c.N = D_SSM; c.K = D_SSM; c.k0 = 64 * (r / 4); c.n0 = 256 * (r % 4); c.i8 = 0; c.sc = WSC; return c; } r -= CV_GLU;
    if (r < CV_OUT) { c.W = a.w_out; c.WT = ws + WS_WOUT; c.N = D; c.K = D; c.k0 = 64 * (r / 8); c.n0 = 256 * (r % 8); c.i8 = 0; c.sc = WSC; c.g0 = a.g_s; c.g1 = a.g_a; return c; } r -= CV_OUT;
    if (r < CV_UP) { c.W = a.w_up; c.WT = ws + WS_WUP; c.N = D_FF; c.K = D; c.k0 = 64 * (r / 32); c.n0 = 256 * (r % 32); c.i8 = 1; c.sc = WU8_S; return c; } r -= CV_UP;
    c.W = a.w_dn; c.WT = ws + WS_WDN; c.N = D; c.K = D_FF; c.k0 = 64 * (r / 8); c.n0 = 256 * (r % 8); c.i8 = 1; c.sc = WD8_S; return c;
}
__device__ __forceinline__ void p0_prologue(const Frame& F, const Args& a) {
    if (F.bx >= NG) {
        const float* c = a.in[1]; const float* w_ada = a.in[3]; float* modp = (float*)(F.ws + WS_SMALL) + SM_MODP;
        LAS float* sil = (LAS float*)(F.lds + RING_BYTES);
        for (int i = F.tid; i < 2 * D; i += 512) { const float cv = c[i]; sil[i] = cv * sigmoidf_(cv); }
        __syncthreads();
        const int item = F.bx - NG, kq = item / 48, cb = item % 48, r0 = kq * 512 + F.wave * 64;
        const float* wp = w_ada + (size_t)r0 * (N_MOD * D) + cb * 256 + 4 * F.lane;
        f32x4 a0 = {0.f, 0.f, 0.f, 0.f}, a1 = {0.f, 0.f, 0.f, 0.f};
#pragma unroll 1
        for (int k0 = 0; k0 < 64; k0 += 16) { f32x4 wv_[16];
#pragma unroll
            for (int j = 0; j < 16; ++j) wv_[j] = *(const f32x4*)(wp + (size_t)(k0 + j) * (N_MOD * D));
#pragma unroll
            for (int j = 0; j < 16; ++j) { const float s0 = sil[r0 + k0 + j], s1 = sil[D + r0 + k0 + j]; a0 += wv_[j] * s0; a1 += wv_[j] * s1; } }
        LAS float* red = (LAS float*)F.lds;
        *(LAS f32x4*)(red + (F.wave * 2 + 0) * 256 + 4 * F.lane) = a0; *(LAS f32x4*)(red + (F.wave * 2 + 1) * 256 + 4 * F.lane) = a1;
        __syncthreads();
        { const int bb = F.tid >> 8, col = F.tid & 255; float v = 0.f;
#pragma unroll
          for (int w8 = 0; w8 < 8; ++w8) v += red[(w8 * 2 + bb) * 256 + col];
          modp[(kq * 2 + bb) * (N_MOD * D) + cb * 256 + col] = v; }
        __syncthreads();
    }
    if (F.bx < NG) p0_tables(F, a, F.bx);
    {
        unsigned* qh = (unsigned*)(F.ws + WS_CTL) + CW_QH; volatile LAS unsigned* MQ = (volatile LAS unsigned*)(F.lds + MISC_OFF) + 16;
        const int lane = F.lane, w = F.wave; const CvSrc cs{a.in[6], a.in[15], a.in[21], a.in[23], a.in[24], a.in[19], a.in[20]};
#define CV_DMA(it_, buf_) do { const CvItem c_ = cv_decode(cs, F.ws, (int)(it_)); int col_ = c_.n0 + 4 * (lane ^ (2 * w)); if (col_ >= c_.N) col_ = c_.n0; \
        const float* src_ = c_.W + (size_t)(c_.k0 + 8 * w) * c_.N + col_; \
        _Pragma("unroll") for (int rr_ = 0; rr_ < 8; ++rr_) __builtin_amdgcn_global_load_lds((const unsigned*)(src_ + (size_t)rr_ * c_.N), (LAS unsigned*)(F.lds + (buf_) * 65536 + (8 * w + rr_) * 1024), 16, 0, 0); } while (0)
        unsigned cur = (unsigned)F.bx, nxt = (unsigned)(F.G + F.bx);
        if (cur < (unsigned)CV_NITEMS) CV_DMA(cur, 0);
#pragma unroll 1
        for (int i = 0; cur < (unsigned)CV_NITEMS; ++i) {
            asm volatile("s_waitcnt vmcnt(0)" ::: "memory"); __syncthreads();
            if (i > 0) nxt = MQ[(i - 1) & 1];
            if (nxt < (unsigned)CV_NITEMS) CV_DMA(nxt, (i + 1) & 1);
            if (F.tid == 0) MQ[i & 1] = __hip_atomic_fetch_add(qh, 1u, RLX_AGENT) + 2u * (unsigned)F.G;
            const CvItem c = cv_decode(cs, F.ws, (int)cur); const LAS unsigned char* buf = F.lds + (i & 1) * 65536;
            if (c.i8) { const int cc = lane & 3, nn = lane >> 2;
#pragma unroll
                for (int j = 0; j < 2; ++j) { const int ncol = 32 * w + 16 * j + nn; float v[16];
#pragma unroll
                    for (int e = 0; e < 16; ++e) { const int row = 16 * cc + e; v[e] = *(const LAS float*)(buf + row * 1024 + (((ncol >> 2) ^ (2 * (2 * cc + (e >> 3)))) << 4) + (ncol & 3) * 4); }
                    u32x4 o; o.x = pk4i8(v[0], v[1], v[2], v[3], c.sc); o.y = pk4i8(v[4], v[5], v[6], v[7], c.sc); o.z = pk4i8(v[8], v[9], v[10], v[11], c.sc); o.w = pk4i8(v[12], v[13], v[14], v[15], c.sc);
                    *(GAS u32x4*)(c.WT + (size_t)(c.n0 + ncol) * c.K + c.k0 + 16 * cc) = o; }
            } else { const int cc = lane & 7, nn = lane >> 3; float gg[8];
#pragma unroll
                for (int e = 0; e < 8; ++e) gg[e] = c.sc;
                if (c.g0) { const float* gp = (c.k0 < 1024 ? c.g0 + c.k0 : c.g1 + (c.k0 - 1024)) + 8 * cc;
#pragma unroll
                    for (int e = 0; e < 8; ++e) gg[e] *= gp[e]; }
#pragma unroll
                for (int j = 0; j < 4; ++j) { const int ncol = 32 * w + 8 * j + nn; const bool ok = c.n0 + ncol < c.N; float v[8];
#pragma unroll
                    for (int e = 0; e < 8; ++e) { const int row = 8 * cc + e; const float t = *(const LAS float*)(buf + row * 1024 + (((ncol >> 2) ^ (2 * cc)) << 4) + (ncol & 3) * 4); v[e] = ok ? t * gg[e] : 0.f; }
                    u32x4 o; o.x = pkh(v[0], v[1]); o.y = pkh(v[2], v[3]); o.z = pkh(v[4], v[5]); o.w = pkh(v[6], v[7]);
                    *(GAS u32x4*)(c.WT + ((size_t)(c.n0 + ncol) * c.K + c.k0 + 8 * cc) * 2) = o; }
            }
            cur = nxt; }
#undef CV_DMA
        asm volatile("s_waitcnt vmcnt(0)" ::: "memory"); __syncthreads();
    }
}

__device__ __forceinline__ void p1_norm(const Frame& F, const Args& a) {
    const int rows_per = M / F.G, r0 = F.bx * rows_per, b = r0 / SEQ;
    LAS float* sc = (LAS float*)F.lds; LAS float* sh = sc + D;
    const float* modp = (const float*)(F.ws + WS_SMALL) + SM_MODP; const float* b_ada = a.in[4]; float* vec = (float*)(F.ws + WS_SMALL) + SM_VEC + b * 6 * D;
    for (int i = F.tid; i < 2 * D; i += 512) { float v = b_ada[i];
#pragma unroll
        for (int kq = 0; kq < 4; ++kq) v += modp[(kq * 2 + b) * (N_MOD * D) + i];
        const int j = i / D, k = i % D;
        if (j == 0) sh[k] = v; else sc[k] = a.in[5][k] * (1.0f + v); }
    if (F.tid < 64) {
        const int e = ((r0 % SEQ) / rows_per) * 64 + F.tid, j = 2 + e / D, k = e % D, i = j * D + k; float v = b_ada[i];
#pragma unroll
        for (int kq = 0; kq < 4; ++kq) v += modp[(kq * 2 + b) * (N_MOD * D) + i];
        if (j == 2) vec[0 * D + k] = v; else if (j == 3) vec[2 * D + k] = v; else if (j == 4) vec[1 * D + k] = a.in[22][k] * (1.0f + v); else vec[3 * D + k] = v; }
    __syncthreads();
    const float* x = a.in[0]; f16* X16 = (f16*)(F.ws + WS_X16);
    for (int r = r0 + F.wave; r < r0 + rows_per; r += NWAVES) {
        const GAS f32x4* xr = (const GAS f32x4*)(x + (size_t)r * D) + F.lane; f32x4 v[8]; float s = 0.f;
#pragma unroll
        for (int j = 0; j < 8; ++j) { v[j] = xr[64 * j]; s += (v[j].x * v[j].x + v[j].y * v[j].y) + (v[j].z * v[j].z + v[j].w * v[j].w); }
        const float rstd = 1.0f / sqrtf(wave_sum(s) * (1.0f / D) + EPS);
        GAS u32x2* o = (GAS u32x2*)(X16 + (size_t)r * D) + F.lane;
#pragma unroll
        for (int j = 0; j < 8; ++j) { const int k = 4 * F.lane + 256 * j; const f32x4 s4 = *(const LAS f32x4*)(sc + k), h4 = *(const LAS f32x4*)(sh + k); const f32x4 y = v[j] * rstd * s4 + h4;
            u32x2 w; w.x = pkh(y.x, y.y); w.y = pkh(y.z, y.w); o[64 * j] = w;
            ((GAS unsigned*)((signed char*)(F.ws + WS_H8) + (size_t)r * D))[F.lane + 64 * j] = pk4i8(y.x, y.y, y.z, y.w, HA8_S); }
    }
    __syncthreads();
}

template <int DRY>
__device__ __forceinline__ void p3_post(const Frame& F, const Args& a) {
    const int* pos = (const int*)a.in[2]; const float *g_q = a.in[17], *g_k = a.in[18];
    f16* Q16 = (f16*)(F.ws + WS_Q16); f16* K16 = (f16*)(F.ws + WS_K16); float* QI32 = (float*)(F.ws + WS_QI32); const float* KW32 = (const float*)(F.ws + WS_KW32);
    f16* KI16 = (f16*)(F.ws + WS_KI16); float* WI32 = (float*)(F.ws + WS_WI32);
    const int lane = F.lane;
    float gq[16], gk[16];
#pragma unroll
    for (int j = 0; j < 16; ++j) { gq[j] = g_q[16 * (lane & 7) + j]; gk[j] = g_k[16 * (lane & 7) + j]; }
    for (int m = F.gw; m < M; m += F.NGW) {
        const float pf = (float)pos[m]; const int ai = lane & 31; const float invf = (float)(ai < 16 ? a.inv16[ai & 15] : a.inv8[ai & 7]); const float angf = pf * invf;
        double sn_, cs_; dsincos((double)angf, sn_, cs_); const float csl = (float)cs_, snl = (float)sn_;
        {
            f16* row = Q16 + (size_t)m * 1024 + 16 * lane; float v[16]; { float t0[8], t1[8]; unpk8(*(const u32x4*)row, t0); unpk8(*(const u32x4*)(row + 8), t1);
#pragma unroll
                for (int j = 0; j < 8; ++j) { v[j] = t0[j]; v[8 + j] = t1[j]; } }
            float ss = 0.f;
#pragma unroll
            for (int j = 0; j < 16; ++j) ss += v[j] * v[j];
            ss += __shfl_xor(ss, 1); ss += __shfl_xor(ss, 2); ss += __shfl_xor(ss, 4);
            const float rstd = 1.0f / sqrtf(ss * (1.0f / HD) + EPS);
#pragma unroll
            for (int j = 0; j < 16; ++j) v[j] = v[j] * rstd * gq[j];
            const int l8 = lane & 7;
#pragma unroll
            for (int j = 0; j < 16; ++j) { const float other = __shfl_xor(v[j], 1); const float cs = __shfl(csl, j), sn = __shfl(snl, j);
                if (l8 == 0) v[j] = v[j] * cs - other * sn; else if (l8 == 1) v[j] = other * sn + v[j] * cs; }
            u32x4 q8; q8.x = pk4i8(v[0], v[1], v[2], v[3]); q8.y = pk4i8(v[4], v[5], v[6], v[7]); q8.z = pk4i8(v[8], v[9], v[10], v[11]); q8.w = pk4i8(v[12], v[13], v[14], v[15]);
            asm volatile("s_waitcnt vmcnt(0)" ::: "memory");
            if (!DRY || pf < -1e30f) *(u32x4*)((char*)(Q16 + (size_t)m * 1024) + 16 * lane) = q8;
        }
        {
            const bool act = lane < 16; f16* row = K16 + (size_t)m * 256 + 16 * (lane & 15); float v[16]; { float t0[8], t1[8]; unpk8(*(const u32x4*)row, t0); unpk8(*(const u32x4*)(row + 8), t1);
#pragma unroll
                for (int j = 0; j < 8; ++j) { v[j] = t0[j]; v[8 + j] = t1[j]; } }
            float ss = 0.f;
#pragma unroll
            for (int j = 0; j < 16; ++j) ss += v[j] * v[j];
            ss += __shfl_xor(ss, 1); ss += __shfl_xor(ss, 2); ss += __shfl_xor(ss, 4);
            const float rstd = 1.0f / sqrtf(ss * (1.0f / HD) + EPS);
#pragma unroll
            for (int j = 0; j < 16; ++j) v[j] = v[j] * rstd * gk[j];
            const int l8 = lane & 7;
#pragma unroll
            for (int j = 0; j < 16; ++j) { const float other = __shfl_xor(v[j], 1); const float cs = __shfl(csl, j), sn = __shfl(snl, j);
                if (l8 == 0) v[j] = v[j] * cs - other * sn; else if (l8 == 1) v[j] = other * sn + v[j] * cs; }
            u32x4 k8; k8.x = pk4i8(v[0], v[1], v[2], v[3]); k8.y = pk4i8(v[4], v[5], v[6], v[7]); k8.z = pk4i8(v[8], v[9], v[10], v[11]); k8.w = pk4i8(v[12], v[13], v[14], v[15]);
            asm volatile("s_waitcnt vmcnt(0)" ::: "memory");
            if (act && (!DRY || pf < -1e30f)) *(u32x4*)((char*)(F.ws + WS_K8) + ((size_t)(lane >> 3) * M + m) * 128 + 16 * (lane & 7)) = k8;
        }
        {
            f16* V16p = (f16*)(F.ws + WS_V16); const f16* row = V16p + (size_t)m * 256 + 16 * (lane & 15); float t0[8], t1[8]; unpk8(*(const u32x4*)row, t0); unpk8(*(const u32x4*)(row + 8), t1);
            u32x4 v8; v8.x = pk4i8(t0[0], t0[1], t0[2], t0[3], V8_S); v8.y = pk4i8(t0[4], t0[5], t0[6], t0[7], V8_S); v8.z = pk4i8(t1[0], t1[1], t1[2], t1[3], V8_S); v8.w = pk4i8(t1[4], t1[5], t1[6], t1[7], V8_S);
            asm volatile("s_waitcnt vmcnt(0)" ::: "memory");
            if (lane < 16 && (!DRY || pf < -1e30f)) *(u32x4*)((char*)(F.ws + WS_V8) + ((size_t)(lane >> 3) * M + m) * 128 + 16 * (lane & 7)) = v8;
        }
        {
            float* row = QI32 + (size_t)m * 1024 + 16 * lane; f32x4 t[4];
#pragma unroll
            for (int j = 0; j < 4; ++j) t[j] = *(const f32x4*)(row + 4 * j);
            float v[16];
#pragma unroll
            for (int j = 0; j < 16; ++j) v[j] = t[j >> 2][j & 3];
            float cs8[8], sn8[8];
#pragma unroll
            for (int j = 0; j < 8; ++j) { cs8[j] = __shfl(csl, 16 + j); sn8[j] = __shfl(snl, 16 + j); }
            if ((lane & 3) == 0) {
#pragma unroll
                for (int j = 0; j < 8; ++j) { const float x1 = v[j], x2 = v[8 + j]; v[j] = x1 * cs8[j] - x2 * sn8[j]; v[8 + j] = x1 * sn8[j] + x2 * cs8[j]; } }
            asm volatile("s_waitcnt vmcnt(0)" ::: "memory");
            f32x4 o0 = {v[0], v[1], v[2], v[3]}, o1 = {v[4], v[5], v[6], v[7]}, o2 = {v[8], v[9], v[10], v[11]}, o3 = {v[12], v[13], v[14], v[15]};
            f16* orow = (f16*)(QI32 + (size_t)m * 1024) + 16 * lane;
            if (!DRY || pf < -1e30f) { *(u32x4*)orow = pk8(o0, o1); *(u32x4*)(orow + 8) = pk8(o2, o3); }
            if (lane < 4) { const float* kr = KW32 + (size_t)m * 256 + 16 * lane; float kv[16];
#pragma unroll
                for (int j = 0; j < 16; ++j) kv[j] = kr[j];
                if (lane == 0) {
#pragma unroll
                    for (int j = 0; j < 8; ++j) { const float x1 = kv[j], x2 = kv[8 + j]; kv[j] = x1 * cs8[j] - x2 * sn8[j]; kv[8 + j] = x1 * sn8[j] + x2 * cs8[j]; } }
                f32x4 p0 = {kv[0], kv[1], kv[2], kv[3]}, p1 = {kv[4], kv[5], kv[6], kv[7]}, p2 = {kv[8], kv[9], kv[10], kv[11]}, p3 = {kv[12], kv[13], kv[14], kv[15]};
                f16* ko = KI16 + ((size_t)((m >> 5) * 4 + lane) * 64 + (m & 31)) * 8; if (!DRY || pf < -1e30f) { *(u32x4*)ko = pk8(p0, p1); *(u32x4*)(ko + 32 * 8) = pk8(p2, p3); } }
            if (lane < 16 && (!DRY || pf < -1e30f)) WI32[(size_t)m * 16 + lane] = KW32[(size_t)m * 256 + 64 + lane] * (1.0f / 32.0f);
        }
    }
    {
        const signed char* WUP = (const signed char*)(F.ws + WS_WUP); const float* vec = (const float*)(F.ws + WS_SMALL) + SM_VEC; float* bias2 = (float*)(F.ws + WS_SMALL) + SM_BIAS2;
        for (int n = F.gw; n < D_FF; n += F.NGW) { float s0 = 0.f, s1 = 0.f;
#pragma unroll
            for (int j = 0; j < 2; ++j) { const int k = 16 * lane + 1024 * j; const u32x4 wq = *(const u32x4*)(WUP + (size_t)n * D + k);
#pragma unroll
                for (int e = 0; e < 16; ++e) { const unsigned wd = e < 4 ? wq.x : e < 8 ? wq.y : e < 12 ? wq.z : wq.w; const float w = (float)(int)(signed char)((wd >> (8 * (e & 3))) & 255u); s0 += w * vec[2 * D + k + e]; s1 += w * vec[6 * D + 2 * D + k + e]; } }
            s0 = wave_sum(s0); s1 = wave_sum(s1);
            if (lane == 0 && (!DRY || s0 == 123456.789f)) { bias2[n] = s0 * (1.0f / WU8_S); bias2[D_FF + n] = s1 * (1.0f / WU8_S); } }
    }
    {
        const signed char* WDN = (const signed char*)(F.ws + WS_WDN); float* csum = (float*)(F.ws + WS_SMALL) + SM_CSUM;
        for (int n = F.gw; n < D; n += F.NGW) { int acc = 0;
#pragma unroll
            for (int j = 0; j < 8; ++j) { const u32x4 wq = *(const u32x4*)(WDN + (size_t)n * D_FF + 16 * lane + 1024 * j);
#pragma unroll
                for (int e = 0; e < 16; ++e) { const unsigned wd = e < 4 ? wq.x : e < 8 ? wq.y : e < 12 ? wq.z : wq.w; acc += (int)(signed char)((wd >> (8 * (e & 3))) & 255u); } }
#pragma unroll
            for (int o = 1; o < 64; o <<= 1) acc += __shfl_xor(acc, o);
            if (lane == 0 && (!DRY || acc == 123456789)) csum[n] = (float)acc; }
    }
}

__device__ __forceinline__ void p4_scan(const Frame& F) {
    if (F.bx >= 128) return;
    const int g = F.bx & 63, b = F.bx >> 6, p = F.lane, w = F.wave;
    const float* lamT = (const float*)(F.ws + WS_SMALL) + SM_LAMT; const float lr = lamT[(g * 64 + p) * 2], li = lamT[(g * 64 + p) * 2 + 1];
    const float* E = (const float*)(F.ws + WS_E32) + ((size_t)g * 512 + b * NCH + 32 * w) * 128; f16* SP_ = (f16*)(F.ws + WS_SPREV) + ((size_t)g * 512 + b * NCH + 32 * w) * 256;
    LAS float* tl = (LAS float*)F.lds;
    float er[32], ei[32];
#pragma unroll
    for (int j = 0; j < 32; ++j) { er[j] = E[(size_t)j * 128 + p]; ei[j] = E[(size_t)j * 128 + 64 + p]; }
    float sr = 0.f, si = 0.f;
#pragma unroll
    for (int j = 0; j < 32; ++j) { const float nr = lr * sr - li * si + er[j], ni = lr * si + li * sr + ei[j]; er[j] = sr; ei[j] = si; sr = nr; si = ni; }
    tl[(w * 2 + 0) * 64 + p] = sr; tl[(w * 2 + 1) * 64 + p] = si;
    float l32r = lr, l32i = li;
#pragma unroll
    for (int q = 0; q < 5; ++q) { const float nr = l32r * l32r - l32i * l32i, ni = 2.f * l32r * l32i; l32r = nr; l32i = ni; }
    __syncthreads();
    float cr = 0.f, ci = 0.f;
    for (int v = 0; v < w; ++v) { const float tr = tl[(v * 2 + 0) * 64 + p], ti = tl[(v * 2 + 1) * 64 + p]; const float nr = l32r * cr - l32i * ci + tr, ni = l32r * ci + l32i * cr + ti; cr = nr; ci = ni; }
#pragma unroll
    for (int j = 0; j < 32; ++j) { f16* row = SP_ + (size_t)j * 256; row[p] = (f16)(er[j] + cr); row[64 + p] = (f16)(ei[j] + ci); *(unsigned*)(row + 128 + 2 * p) = 0u;
        const float nr = lr * cr - li * ci, ni = lr * ci + li * cr; cr = nr; ci = ni; }
    asm volatile("s_waitcnt vmcnt(0)" ::: "memory");
    __syncthreads();
    if (F.tid == 0) { __builtin_amdgcn_fence(__ATOMIC_RELEASE, "agent"); asm volatile("s_waitcnt vmcnt(0)" ::: "memory"); (void)xb_add((unsigned*)(F.ws + WS_CTL) + CW_SCAN, 1u); }
}

constexpr int IX_QB = 32, IX_CAP = 512, IX_TRIG = IX_CAP - 64;
constexpr int IXL_CS = 0, IXL_CI = IX_QB * IX_CAP * 4, IXL_KT = IXL_CI + IX_QB * IX_CAP * 2, IXL_HIST = IXL_KT + 4 * 8192, IXL_FLAG = IXL_HIST + 8 * 512;
constexpr int IX_SOFT = 416, IX_MINC = 320;
static_assert(IXL_FLAG + 64 <= MISC_OFF, "indexer lds");
__device__ __forceinline__ unsigned f2key(float f) { const unsigned u = __builtin_bit_cast(unsigned, f); return (u & 0x80000000u) ? ~u : (u | 0x80000000u); }
__device__ __forceinline__ float key2f(unsigned k) { const unsigned u = (k & 0x80000000u) ? (k & 0x7fffffffu) : ~k; return __builtin_bit_cast(float, u); }
__device__ __forceinline__ int ix_select(LAS unsigned char* lds, int q, int lane, int n) {
    LAS float* cs = (LAS float*)(lds + IXL_CS) + q * IX_CAP; LAS u16* ci = (LAS u16*)(lds + IXL_CI) + q * IX_CAP;
    unsigned key[8]; unsigned idx[8];
#pragma unroll
    for (int i = 0; i < 8; ++i) { const int e = lane + 64 * i; const bool v = e < n; key[i] = v ? f2key(cs[e]) : 0u; idx[i] = v ? (unsigned)ci[e] : 0u; }
    unsigned T = 0u;
#pragma unroll 1
    for (int bit = 31; bit >= 0; --bit) { const unsigned cand = T | (1u << bit); int c = 0;
#pragma unroll
        for (int i = 0; i < 8; ++i) c += __popcll(__ballot(key[i] >= cand));
        if (c >= TOPK) T = cand; }
    int cgt = 0;
#pragma unroll
    for (int i = 0; i < 8; ++i) cgt += __popcll(__ballot(key[i] > T));
    int need = TOPK - cgt, base = 0;
    LDS_WAIT(); asm volatile("" ::: "memory");
#pragma unroll
    for (int i = 0; i < 8; ++i) {
        const bool gt = key[i] > T, eq = key[i] == T && T != 0u;
        const unsigned long long meq = __ballot(eq); const int eqrank = __popcll(meq & ((1ull << lane) - 1ull)); const bool take = gt || (eq && eqrank < need);
        const unsigned long long mt = __ballot(take); const int pos = base + __popcll(mt & ((1ull << lane) - 1ull));
        if (take) { cs[pos] = key2f(key[i]); ci[pos] = (u16)idx[i]; }
        base += __popcll(mt); const int teq = __popcll(meq); need -= teq < need ? teq : need;
    }
    LDS_WAIT(); asm volatile("" ::: "memory");
    return base;
}
#define DPP_ROW_SHR(n) (0x110 + (n))
#define DPP_ROW_ROR(n) (0x120 + (n))
__device__ __forceinline__ float dpp_rowf(float v, const int ctrl_unused) { return v; }
template <int CTRL> __device__ __forceinline__ int dpp_i(int v) { return __builtin_amdgcn_update_dpp(0, v, CTRL, 0xf, 0xf, true); }
template <int CTRL> __device__ __forceinline__ float dpp_f(float v) { return __builtin_bit_cast(float, __builtin_amdgcn_update_dpp(0, __builtin_bit_cast(int, v), CTRL, 0xf, 0xf, true)); }
__device__ __forceinline__ float wave_max_s(float v) {
    v = fmaxf(v, dpp_f<DPP_ROW_ROR(8)>(v)); v = fmaxf(v, dpp_f<DPP_ROW_ROR(4)>(v)); v = fmaxf(v, dpp_f<DPP_ROW_ROR(2)>(v)); v = fmaxf(v, dpp_f<DPP_ROW_ROR(1)>(v));
    const int iv = __builtin_bit_cast(int, v);
    const float a = __builtin_bit_cast(float, __builtin_amdgcn_readlane(iv, 0)), b = __builtin_bit_cast(float, __builtin_amdgcn_readlane(iv, 16)), c = __builtin_bit_cast(float, __builtin_amdgcn_readlane(iv, 32)), d = __builtin_bit_cast(float, __builtin_amdgcn_readlane(iv, 48));
    return fmaxf(fmaxf(a, b), fmaxf(c, d));
}
__device__ __forceinline__ float wave_min_s(float v) { return -wave_max_s(-v); }
__device__ __forceinline__ int wave_prefix_sum(int v, int lane) {
    v += dpp_i<DPP_ROW_SHR(1)>(v); v += dpp_i<DPP_ROW_SHR(2)>(v); v += dpp_i<DPP_ROW_SHR(4)>(v); v += dpp_i<DPP_ROW_SHR(8)>(v);
    const int r0 = __builtin_amdgcn_readlane(v, 15), r1 = __builtin_amdgcn_readlane(v, 31), r2 = __builtin_amdgcn_readlane(v, 47);
    return v + (lane >= 16 ? r0 : 0) + (lane >= 32 ? r1 : 0) + (lane >= 48 ? r2 : 0);
}
__device__ __forceinline__ int ix_compact(LAS unsigned char* lds, LAS int* hist, int q, int lane, int n, float& tau_out) {
    LAS float* cs = (LAS float*)(lds + IXL_CS) + q * IX_CAP; LAS u16* ci = (LAS u16*)(lds + IXL_CI) + q * IX_CAP;
    float v[8]; unsigned idx[8]; float vmin = INFINITY, vmax = -INFINITY;
#pragma unroll
    for (int i = 0; i < 8; ++i) { const int e = lane + 64 * i; const bool ok = e < n; v[i] = ok ? cs[e] : -INFINITY; idx[i] = ok ? (unsigned)ci[e] : 0u; if (ok) { vmin = fminf(vmin, v[i]); vmax = fmaxf(vmax, v[i]); } }
    vmin = wave_min_s(vmin); vmax = wave_max_s(vmax);
    const float range = vmax - vmin;
    bool okk = range > 0.f && range < 1e30f;
    int b1[8], b2[8]; int bs = 0, ss = 0;
    if (okk) {
        const float sc1 = 64.0f / range;
        hist[lane] = 0; hist[64 + lane] = 0;
#pragma unroll
        for (int i = 0; i < 8; ++i) { int bb = (int)((v[i] - vmin) * sc1); bb = bb > 63 ? 63 : bb; b1[i] = (lane + 64 * i < n) ? 63 - bb : 64; if (b1[i] < 64) __hip_atomic_fetch_add(hist + b1[i], 1, __ATOMIC_RELAXED, __HIP_MEMORY_SCOPE_WAVEFRONT); }
        LDS_WAIT(); asm volatile("" ::: "memory");
        const int h1 = hist[lane]; const int P1 = wave_prefix_sum(h1, lane);
        const unsigned long long m1 = __ballot(P1 >= TOPK); bs = __builtin_ctzll(m1);
        const int above = __builtin_amdgcn_readlane(P1 - h1, bs);
        const int hb = __builtin_amdgcn_readlane(h1, bs);
        ss = 63;
#pragma unroll
        for (int i = 0; i < 8; ++i) b2[i] = 0;
        int cnt_keep = above + hb;
        if (cnt_keep > IX_SOFT - 64) {
            const int need = TOPK - above;
            const float lo1 = vmin + (float)(63 - bs) / sc1; const float sc2 = sc1 * 64.0f;
#pragma unroll
            for (int i = 0; i < 8; ++i) { int bb = (int)((v[i] - lo1) * sc2); bb = bb < 0 ? 0 : (bb > 63 ? 63 : bb); b2[i] = 63 - bb; if (b1[i] == bs) __hip_atomic_fetch_add(hist + 64 + b2[i], 1, __ATOMIC_RELAXED, __HIP_MEMORY_SCOPE_WAVEFRONT); }
            LDS_WAIT(); asm volatile("" ::: "memory");
            const int h2 = hist[64 + lane]; const int P2 = wave_prefix_sum(h2, lane);
            const unsigned long long m2 = __ballot(P2 >= need); ss = __builtin_ctzll(m2);
            cnt_keep = above + __builtin_amdgcn_readlane(P2, ss);
        }
        okk = cnt_keep <= IX_SOFT - 64;
    }
    if (!okk) { const int nn = ix_select(lds, q, lane, n); float t = INFINITY;
#pragma unroll
        for (int i = 0; i < 4; ++i) { const int e = lane + 64 * i; if (e < nn) t = fminf(t, cs[e]); }
        tau_out = wave_min_s(t); return nn; }
    int base = 0; float tmin = INFINITY;
    LDS_WAIT(); asm volatile("" ::: "memory");
#pragma unroll
    for (int i = 0; i < 8; ++i) {
        const bool take = b1[i] < bs || (b1[i] == bs && b2[i] <= ss);
        const unsigned long long mt = __ballot(take); const int pos = base + __popcll(mt & ((1ull << lane) - 1ull));
        if (take) { cs[pos] = v[i]; ci[pos] = (u16)idx[i]; tmin = fminf(tmin, v[i]); }
        base += __popcll(mt);
    }
    LDS_WAIT(); asm volatile("" ::: "memory");
    tau_out = wave_min_s(tmin);
    return base;
}
template <int MODE>
__device__ __forceinline__ void p4_indexer(const Frame& F) {
    LAS unsigned char* lds = F.lds; const int lane = F.lane, w = F.wave;
    LAS float* cs = (LAS float*)(lds + IXL_CS); LAS u16* ci = (LAS u16*)(lds + IXL_CI); LAS int* hist = (LAS int*)(lds + IXL_HIST) + w * 128; volatile LAS int* flags = (volatile LAS int*)(lds + IXL_FLAG);
    const f16* QI16 = (const f16*)(F.ws + WS_QI32); const f16* KIF = (const f16*)(F.ws + WS_KI16); const float* WI32 = (const float*)(F.ws + WS_WI32); u16* SEL = (u16*)(F.ws + WS_SEL);
    const int nunits = BATCH * (SEQ / IX_QB);
    const int hl = lane >> 5, l31 = lane & 31;
    (void)nunits;
#pragma unroll 1
    for (int rnd = 0; rnd < 2; ++rnd) {
        int idx = F.bx;
        if (rnd == 1) { if (F.tid == 0) flags[8] = (int)xb_add((unsigned*)(F.ws + WS_CTL) + CW_IXQ, 1u); __syncthreads(); idx = flags[8]; }
        const int b = idx & 1; const int jj = idx >> 1;
        const int nqb = SEQ / IX_QB; const int qb = (rnd & 1) ? (nqb / 2 - 1 - jj) : (nqb - 1 - jj);
        const int t0 = qb * IX_QB; const size_t mb = (size_t)b * SEQ;
        if (F.tid < 3) flags[F.tid] = 0;
        half8 Af[2][4]; f32x2 wv[2][8]; float tq[2]; int cn[4] = {0, 0, 0, 0};
        { const int mrow = l31, qs = (mrow >> 2) & 1, hd = 4 * (mrow >> 3) + (mrow & 3);
#pragma unroll
            for (int rt = 0; rt < 2; ++rt) { const size_t tok = mb + t0 + 4 * w + 2 * rt + qs; const f16* src = QI16 + tok * 2048 + hd * 64 + 8 * hl;
#pragma unroll
                for (int s = 0; s < 4; ++s) Af[rt][s] = *(const half8*)(src + 16 * s);
                const size_t tokw = mb + t0 + 4 * w + 2 * rt + hl;
#pragma unroll
                for (int i = 0; i < 8; ++i) wv[rt][i] = *(const f32x2*)(WI32 + tokw * 16 + 2 * i);
                tq[rt] = (MODE != 0 && MODE != 2) ? INFINITY : -INFINITY; }
#pragma unroll
            for (int rt = 0; rt < 2; ++rt) {
#pragma unroll
                for (int s = 0; s < 4; ++s) asm volatile("" : "+v"(Af[rt][s]));
#pragma unroll
                for (int i = 0; i < 8; ++i) asm volatile("" : "+v"(wv[rt][i])); } }
        const int npair = ((t0 + IX_QB - 1) / 32 + 2) / 2;
        const f16* kbase = KIF + (size_t)(b * (SEQ / 32)) * 4 * 64 * 8 + (size_t)F.tid * 8;
#define IX_DMA(tile) __builtin_amdgcn_global_load_lds((const unsigned*)(kbase + (size_t)(tile) * 4096), (LAS unsigned*)(lds + IXL_KT + ((tile) & 3) * 8192 + w * 1024), 16, 0, 0)
        LDS_WAIT(); __builtin_amdgcn_s_barrier();
        IX_DMA(0); if (npair > 1) IX_DMA(1); if (npair > 2) IX_DMA(2);
        if (npair > 2) asm volatile("s_waitcnt vmcnt(2)" ::: "memory"); else if (npair > 1) asm volatile("s_waitcnt vmcnt(1)" ::: "memory"); else asm volatile("s_waitcnt vmcnt(0)" ::: "memory");
        LDS_WAIT(); __builtin_amdgcn_s_barrier(); asm volatile("" ::: "memory");
        f32x16 accA[2], accB[2];
#define IX_MMA(ACC, BF) do { _Pragma("unroll") for (int rt = 0; rt < 2; ++rt) { ACC[rt] = (f32x16){}; \
            if (MODE == 3 || MODE == 5) { _Pragma("unroll") for (int i = 0; i < 16; ++i) ACC[rt][i] = (float)BF[i & 3][i >> 2] + (float)Af[rt][i & 3][i >> 2]; } \
            else { _Pragma("unroll") for (int s = 0; s < 4; ++s) ACC[rt] = __builtin_amdgcn_mfma_f32_32x32x16_f16(Af[rt][s], BF[s], ACC[rt], 0, 0, 0); } } } while (0)
#define IX_CALC(ACC, S0, S1) do { _Pragma("unroll") for (int rt = 0; rt < 2; ++rt) { \
            float sc = 0.f, sd = 0.f;     \
            _Pragma("unroll") for (int i = 0; i < 4; ++i) { const int a0 = __builtin_bit_cast(int, (float)ACC[rt][2 * i]), a1 = __builtin_bit_cast(int, (float)ACC[rt][2 * i + 1]), b0 = __builtin_bit_cast(int, (float)ACC[rt][8 + 2 * i]), b1 = __builtin_bit_cast(int, (float)ACC[rt][9 + 2 * i]); \
                const int m0 = a0 > 0 ? a0 : 0, m1 = a1 > 0 ? a1 : 0, n0 = b0 > 0 ? b0 : 0, n1 = b1 > 0 ? b1 : 0; \
                sc = __builtin_fmaf(__builtin_bit_cast(float, m0), wv[rt][i].x, sc); sd = __builtin_fmaf(__builtin_bit_cast(float, n0), wv[rt][4 + i].x, sd); asm("" : "+v"(sd));   \
                sc = __builtin_fmaf(__builtin_bit_cast(float, m1), wv[rt][i].y, sc); sd = __builtin_fmaf(__builtin_bit_cast(float, n1), wv[rt][4 + i].y, sd); asm("" : "+v"(sd)); } \
            sc += sd; \
            if (MODE == 4 || MODE == 5) sc = ACC[rt][0] + ACC[rt][7] + ACC[rt][15]; \
            if (rt == 0) S0 = sc; else S1 = sc; } } while (0)
#define IX_APPEND(RT, SC, KEY) do { const int rt = (RT); const int key = (KEY); const float sc = (SC); \
            const int ql = 4 * w + 2 * rt + hl; const int t = t0 + ql; \
            const bool cond = key <= t && sc > tq[rt]; \
            const unsigned long long mask = __ballot(cond); \
            if (mask != 0ull) { \
                const unsigned lo = (unsigned)mask, hi = (unsigned)(mask >> 32); \
                const unsigned mym = hl ? hi : lo; const int rank = __popc(mym & ((1u << l31) - 1u)); \
                const int base = hl ? cn[2 * rt + 1] : cn[2 * rt]; \
                if (cond) { const int pos = base + rank; cs[ql * IX_CAP + pos] = sc; ci[ql * IX_CAP + pos] = (u16)key; } \
                cn[2 * rt] += __popc(lo); cn[2 * rt + 1] += __popc(hi); } } while (0)
#define IX_INTERLEAVE() do { _Pragma("unroll") for (int i_ = 0; i_ < 8; ++i_) { __builtin_amdgcn_sched_group_barrier(0x008, 1, 0); __builtin_amdgcn_sched_group_barrier(0x002, 7, 0); } } while (0)
        for (int tp = 0; tp < npair; ++tp) {
            const int fl = flags[(tp + 2) % 3];
            if (F.tid == 0) flags[(tp + 1) % 3] = 0;
            if (fl != 0) {
#pragma unroll 1
                for (int qq = 0; qq < 4; ++qq) { const int c = qq == 0 ? cn[0] : qq == 1 ? cn[1] : qq == 2 ? cn[2] : cn[3];
                    if (c > IX_MINC) { float tau; const int nn = ix_compact(lds, hist, 4 * w + qq, lane, c, tau);
                        cn[0] = qq == 0 ? nn : cn[0]; cn[1] = qq == 1 ? nn : cn[1]; cn[2] = qq == 2 ? nn : cn[2]; cn[3] = qq == 3 ? nn : cn[3];
                        if (hl == (qq & 1)) { tq[0] = (qq >> 1) == 0 ? tau : tq[0]; tq[1] = (qq >> 1) == 1 ? tau : tq[1]; } } } }
            if (tp + 3 < npair) IX_DMA(tp + 3);
            const LAS unsigned char* kb = lds + IXL_KT + (tp & 3) * 8192 + lane * 16;
            {
                half8 Bf0[4], Bf1[4]; float sB0 = 0.f, sB1 = 0.f, sA0, sA1;
#pragma unroll
                for (int s = 0; s < 4; ++s) Bf0[s] = *(const LAS half8*)(kb + s * 1024);
#pragma unroll
                for (int s = 0; s < 4; ++s) Bf1[s] = *(const LAS half8*)(kb + (4 + s) * 1024);
                if (tp > 0) { IX_MMA(accA, Bf0); IX_CALC(accB, sB0, sB1); IX_INTERLEAVE(); asm volatile("" : "+v"(sB0), "+v"(sB1));
                    IX_APPEND(0, sB0, (2 * tp - 1) * 32 + l31); IX_APPEND(1, sB1, (2 * tp - 1) * 32 + l31); }
                else { IX_MMA(accA, Bf0); }
                IX_MMA(accB, Bf1); IX_CALC(accA, sA0, sA1); IX_INTERLEAVE(); asm volatile("" : "+v"(sA0), "+v"(sA1));
                IX_APPEND(0, sA0, (2 * tp) * 32 + l31); IX_APPEND(1, sA1, (2 * tp) * 32 + l31); }
            if ((cn[0] > IX_SOFT || cn[1] > IX_SOFT || cn[2] > IX_SOFT || cn[3] > IX_SOFT) && lane == 0) flags[tp % 3] = 1;
            if (tp + 3 < npair) asm volatile("s_waitcnt vmcnt(2)" ::: "memory"); else if (tp + 2 < npair) asm volatile("s_waitcnt vmcnt(1)" ::: "memory"); else asm volatile("s_waitcnt vmcnt(0)" ::: "memory");
            LDS_WAIT(); __builtin_amdgcn_s_barrier(); asm volatile("" ::: "memory");
        }
        { float sB0, sB1; IX_CALC(accB, sB0, sB1); IX_APPEND(0, sB0, (2 * npair - 1) * 32 + l31); IX_APPEND(1, sB1, (2 * npair - 1) * 32 + l31); }
#undef IX_DMA
#undef IX_MMA
#undef IX_CALC
#undef IX_APPEND
#undef IX_INTERLEAVE
        if (MODE == 0)
#pragma unroll 1
        for (int qq = 0; qq < 4; ++qq) { const int q = 4 * w + qq; int n = qq == 0 ? cn[0] : qq == 1 ? cn[1] : qq == 2 ? cn[2] : cn[3]; if (n > TOPK) n = ix_select(lds, q, lane, n);
            LDS_WAIT(); u16* dst = SEL + (mb + t0 + q) * TOPK;
#pragma unroll
            for (int i = 0; i < 4; ++i) { const int e = lane + 64 * i; dst[e] = e < n ? ci[q * IX_CAP + e] : (u16)0; } }
    }
    asm volatile("s_waitcnt vmcnt(0) lgkmcnt(0)" ::: "memory"); __syncthreads();
}

typedef short short4v __attribute__((ext_vector_type(4)));
typedef short short8v __attribute__((ext_vector_type(8)));
typedef int i32x2v __attribute__((ext_vector_type(2)));
constexpr int ATL_WAVE = 19968, ATL_SEL = 0, ATL_OST = 512, ATL_KST = 1536, ATL_VR = 3584;
static_assert(ATL_WAVE * NWAVES <= MISC_OFF, "attention lds");
template <int MODE>
__device__ __forceinline__ void p7_attn(const Frame& F, const Args& a) {
    const int lane = F.lane; LAS unsigned char* wl = F.lds + F.wave * ATL_WAVE;
    LAS u16* lsel = (LAS u16*)(wl + ATL_SEL); LAS unsigned char* ost = wl + ATL_OST; LAS unsigned char* vring = wl + ATL_VR;
    const unsigned kst = (unsigned)(__UINTPTR_TYPE__)(wl + ATL_KST);
    const f16* Q16 = (const f16*)(F.ws + WS_Q16); const f16* K16 = (const f16*)(F.ws + WS_K16); const f16* V16 = (const f16*)(F.ws + WS_V16); const u16* SEL = (const u16*)(F.ws + WS_SEL);
    f16* MIX = (f16*)(F.ws + WS_MIX);
    const int hq = lane & 15, kq = lane >> 4;
    const int g = F.bx & 1; const char* K8g = (const char*)(F.ws + WS_K8) + (size_t)g * M * 128; const char* V8g = (const char*)(F.ws + WS_V8) + (size_t)g * M * 128;
    const int bsel = (F.bx >> 1) & 1; const int gwh = (F.bx >> 2) * NWAVES + F.wave, NGH = (F.G >> 2) * NWAVES; float* rsa2 = (float*)(F.ws + WS_CTL) + CW_RSA2;
#define AT_RHO(i_) (8 * (i_) + (lane >> 3))
#define AT_DSLOT(i_) (16 * ((AT_RHO(i_) >> 2) & 3) + 4 * (AT_RHO(i_) >> 4) + (AT_RHO(i_) & 3))
#define AT_DSRC(i_) ((unsigned)((((lane & 7) ^ (AT_RHO(i_) & 7)) * 16)))
    unsigned tra[2]; int trx[2];
    { const int r_ = hq >> 1, c_ = lane & 1;
#pragma unroll
        for (int h = 0; h < 2; ++h) { const int R = 16 * kq + 8 * h + r_; trx[h] = R & 7; tra[h] = (unsigned)(128 * R + 8 * c_); } }
#define AT_DMA(c, buf) do { unsigned z_ = 0u; asm volatile("" : "+v"(z_));   \
        _Pragma("unroll") for (int i_ = 0; i_ < 8; ++i_) { const unsigned idx_ = ((i_ & 1) ? (dpk[c][i_ >> 1] >> 16) : (dpk[c][i_ >> 1] & 0xffffu)) + z_; \
        __builtin_amdgcn_global_load_lds((const unsigned*)(V8g + ((size_t)(mb + idx_) * 128 + AT_DSRC(i_))), (LAS unsigned*)(vring + (buf) * 8192 + i_ * 1024), 16, 0, 0); } } while (0)
    unsigned* aq = (unsigned*)(F.ws + WS_CTL) + CW_ATT + 64 * (g + 2 * bsel);
    for (int mi = gwh; mi < SEQ; ) {
        const int m = bsel * SEQ + mi; const int b = bsel, t = mi; const int nsel = t + 1 < TOPK ? t + 1 : TOPK; const size_t mb = (size_t)b * SEQ; unsigned nx_ = 0u;
        { unsigned lo8 = (unsigned)lane * 8u; asm volatile("" : "+v"(lo8));
          u32x2 sv = *(const u32x2*)((const char*)(SEL + (size_t)m * TOPK) + lo8);
          if (lane == 0) nx_ = __hip_atomic_fetch_add(aq, 1u, RLX_AGENT);
          if (MODE == 1) { sv.x = sv.x == 0xdeadbeefu ? 1u : 0u; sv.y = 0u; } *(LAS u32x2*)(lsel + 4 * lane) = sv; }
        LDS_WAIT(); asm volatile("" ::: "memory");
        unsigned dpk[4][4];
#pragma unroll
        for (int c = 0; c < 2; ++c)
#pragma unroll
            for (int i = 0; i < 4; ++i) dpk[c][i] = (unsigned)lsel[64 * c + AT_DSLOT(2 * i)] | ((unsigned)lsel[64 * c + AT_DSLOT(2 * i + 1)] << 16);
        unsigned kpk[16];
#pragma unroll
        for (int T = 0; T < 16; ++T) kpk[T] = (unsigned)lsel[16 * T + (lane >> 3)] | ((unsigned)lsel[16 * T + 8 + (lane >> 3)] << 16);
        LDS_WAIT(); asm volatile("" ::: "memory");
        AT_DMA(0, 0); AT_DMA(1, 1);
        i32x4 Bq[2];
#pragma unroll
        for (int s = 0; s < 2; ++s) { i32x4 z = {0, 0, 0, 0}; unsigned qlo = (unsigned)((4 * g + hq) * HD + 16 * kq); asm volatile("" : "+v"(qlo)); if (hq < 4) z = *(const i32x4*)((const char*)Q16 + (size_t)m * 2048 + 64 * s + qlo); Bq[s] = z; }
        f32x4 sc[16];
        const unsigned wr0 = kst + (unsigned)((lane >> 3) * 128 + (((lane & 7) ^ (lane >> 3)) * 16)), wr1 = wr0 + 1024u;
        const unsigned rd0 = kst + (unsigned)(hq * 128 + ((kq ^ (hq & 7)) * 16)), rd1 = kst + (unsigned)(hq * 128 + (((kq + 4) ^ (hq & 7)) * 16));
        i32x4 ka[2], kb[2];
        i32x4 kreg[16][2];
#pragma unroll
        for (int T = 0; T < 16; ++T) { const unsigned i0_ = kpk[T] & 0xffffu, i1_ = kpk[T] >> 16;
            kreg[T][0] = *(const i32x4*)(K8g + (mb + i0_) * 128 + 16 * (lane & 7)); kreg[T][1] = *(const i32x4*)(K8g + (mb + i1_) * 128 + 16 * (lane & 7)); }
#define AT_KSTAGE(T_, A0, A1) do { \
            asm volatile("ds_write_b128 %0, %1" :: "v"(wr0), "v"(kreg[T_][0])); asm volatile("ds_write_b128 %0, %1" :: "v"(wr1), "v"(kreg[T_][1])); \
            asm volatile("ds_read_b128 %0, %1" : "=v"(A0) : "v"(rd0)); asm volatile("ds_read_b128 %0, %1" : "=v"(A1) : "v"(rd1)); } while (0)
#define AT_QK(T_, A0, A1) do { i32x4 acc = {0, 0, 0, 0}; acc = __builtin_amdgcn_mfma_i32_16x16x64_i8(A0, Bq[0], acc, 0, 0, 0); acc = __builtin_amdgcn_mfma_i32_16x16x64_i8(A1, Bq[1], acc, 0, 0, 0); \
            constexpr float SCQK = 0.08838834764831845f / (QK8_S * QK8_S);     \
            sc[T_] = (f32x4){(float)acc[0] * SCQK, (float)acc[1] * SCQK, (float)acc[2] * SCQK, (float)acc[3] * SCQK}; } while (0)
        AT_KSTAGE(0, ka[0], ka[1]);
#pragma unroll
        for (int T = 0; T < 16; ++T) {
            if (T + 1 < 16) { if (T & 1) AT_KSTAGE(T + 1, ka[0], ka[1]); else AT_KSTAGE(T + 1, kb[0], kb[1]); }
            if (T & 1) { if (T + 1 < 16) asm volatile("s_waitcnt lgkmcnt(4)" : "+v"(kb[0]), "+v"(kb[1])); else asm volatile("s_waitcnt lgkmcnt(0)" : "+v"(kb[0]), "+v"(kb[1])); AT_QK(T, kb[0], kb[1]); }
            else { asm volatile("s_waitcnt lgkmcnt(4)" : "+v"(ka[0]), "+v"(ka[1])); AT_QK(T, ka[0], ka[1]); } }
#undef AT_KSTAGE
#undef AT_QK
#pragma unroll
        for (int c = 2; c < 4; ++c)
#pragma unroll
            for (int i = 0; i < 4; ++i) dpk[c][i] = (unsigned)lsel[64 * c + AT_DSLOT(2 * i)] | ((unsigned)lsel[64 * c + AT_DSLOT(2 * i + 1)] << 16);
        LDS_WAIT(); asm volatile("" ::: "memory");
        int lim = nsel - 4 * kq; asm volatile("" : "+v"(lim));
        float mx = -INFINITY;
#pragma unroll
        for (int T = 0; T < 16; ++T)
#pragma unroll
            for (int i = 0; i < 4; ++i) mx = fmaxf(mx, sc[T][i]);
        mx = fmaxf(mx, __shfl_xor(mx, 16)); mx = fmaxf(mx, __shfl_xor(mx, 32));
        unsigned p8[16]; int isum = 0;
#pragma unroll
        for (int T = 0; T < 16; ++T) { unsigned w = 0u;
#pragma unroll
            for (int i = 0; i < 4; ++i) { const float p = (16 * T + i < lim) ? __expf(sc[T][i] - mx) : 0.f; const int q = (int)__builtin_rintf(p * 127.0f); isum += q; w |= (unsigned)q << (8 * i); }
            p8[T] = w; }
        isum += __shfl_xor(isum, 16); isum += __shfl_xor(isum, 32);
        i32x4 oacc[8];
#pragma unroll
        for (int dt = 0; dt < 8; ++dt) oacc[dt] = (i32x4){0, 0, 0, 0};
        asm volatile("s_waitcnt vmcnt(0)" ::: "memory");
#pragma unroll
        for (int c = 0; c < 4; ++c) {
            if (c >= 2) { if (c < 3) asm volatile("s_waitcnt vmcnt(8)" ::: "memory"); else asm volatile("s_waitcnt vmcnt(0)" ::: "memory"); }
            const i32x4 pf = {(int)p8[4 * c], (int)p8[4 * c + 1], (int)p8[4 * c + 2], (int)p8[4 * c + 3]};
            const LAS unsigned char* vb = vring + (c & 1) * 8192;
#pragma unroll
            for (int dh = 0; dh < 2; ++dh) {
                i32x2v t0[4], t1[4];
#pragma unroll
                for (int d4 = 0; d4 < 4; ++d4) { const int dt = 4 * dh + d4;
                    t0[d4] = __builtin_amdgcn_ds_read_tr8_b64_v2i32((LAS i32x2v*)(vb + tra[0] + 16 * (dt ^ trx[0])));
                    t1[d4] = __builtin_amdgcn_ds_read_tr8_b64_v2i32((LAS i32x2v*)(vb + tra[1] + 16 * (dt ^ trx[1]))); }
                __builtin_amdgcn_sched_barrier(0);
#pragma unroll
                for (int d4 = 0; d4 < 4; ++d4) { const int dt = 4 * dh + d4; const i32x4 vf = {t0[d4][0], t0[d4][1], t1[d4][0], t1[d4][1]};
                    oacc[dt] = __builtin_amdgcn_mfma_i32_16x16x64_i8(pf, vf, oacc[dt], 0, 0, 0); }
            }
            if (c + 2 < 4) { LDS_WAIT(); asm volatile("" ::: "memory"); AT_DMA(c + 2, c & 1); }
            __builtin_amdgcn_sched_barrier(0);
        }
        float ss = 0.f;
#pragma unroll
        for (int i = 0; i < 4; ++i) { const float inv = 1.0f / (V8_S * (float)__shfl(isum, i));
#pragma unroll
            for (int dt = 0; dt < 8; ++dt) { const float o = (float)oacc[dt][i] * inv; if (kq == 0) { ss += o * o; *(LAS f16*)(ost + (i * HD + 16 * dt + hq) * 2) = (f16)o; } } }
        LDS_WAIT(); asm volatile("" ::: "memory");
        ss = wave_sum(ss);
        unsigned lo16 = (unsigned)lane * 16u; asm volatile("" : "+v"(lo16));
        const u32x4 ov = *(const LAS u32x4*)(ost + lo16);
        if (lane == 0 && (MODE == 0 || ss == 123456.789f)) rsa2[2 * m + g] = ss;
        if (MODE == 0 || ss == 123456.789f) *(u32x4*)(MIX + (size_t)m * D + D_SSM + 4 * g * HD + 8 * lane) = ov;
        LDS_WAIT(); asm volatile("" ::: "memory");
        mi = __builtin_amdgcn_readfirstlane((int)nx_) + NGH;
    }
#undef AT_DMA
#undef AT_RHO
#undef AT_DSLOT
#undef AT_DSRC
}
__device__ __forceinline__ void p7_ssmnorm(const Frame& F, const Args& a) {
    const int lane = F.lane; f16* MIX = (f16*)(F.ws + WS_MIX);
    {
        const float* rss = (const float*)(F.ws + WS_CTL) + CW_RSS; const float* g_os = a.in[19];
        for (int m = F.gw; m < M; m += F.NGW) { const float rstd = 1.0f / sqrtf(rss[m] * (1.0f / D_SSM) + EPS); f16* row = MIX + (size_t)m * D + 16 * lane;
            float v0[8], v1[8]; unpk8(*(const u32x4*)row, v0); unpk8(*(const u32x4*)(row + 8), v1);
            f32x4 o0, o1, o2, o3;
#pragma unroll
            for (int j = 0; j < 4; ++j) { o0[j] = v0[j] * rstd * g_os[16 * lane + j]; o1[j] = v0[4 + j] * rstd * g_os[16 * lane + 4 + j]; o2[j] = v1[j] * rstd * g_os[16 * lane + 8 + j]; o3[j] = v1[4 + j] * rstd * g_os[16 * lane + 12 + j]; }
            *(u32x4*)row = pk8(o0, o1); *(u32x4*)(row + 8) = pk8(o2, o3); }
    }
}

__global__ void __launch_bounds__(NWAVES * 64, 2) hymba_fwd(Args args) {
    extern __shared__ __attribute__((aligned(16))) unsigned char lds_raw[];
    Frame F; F.lds = (LAS unsigned char*)lds_raw; F.tid = threadIdx.x; F.lane = F.tid & 63; F.wave = __builtin_amdgcn_readfirstlane(F.tid >> 6);
    F.G = gridDim.x; F.bx = blockIdx.x; F.gw = F.bx * NWAVES + F.wave; F.NGW = F.G * NWAVES; F.ws = args.ws;
    volatile LAS unsigned* MISC = (volatile LAS unsigned*)(F.lds + MISC_OFF);
    if (F.tid < 64) MISC[F.tid] = 0u;
    __syncthreads();
    unsigned* ctl = (unsigned*)(F.ws + WS_CTL);
    XcdBarrier bar; bar.bar = ctl + CW_BAR; bar.x = 0; bar.st = nullptr;
    if (MK_N_LAUNCHES == 1) bar = xcd_barrier_post(ctl + CW_BAR, MISC + 8);
    const int lo = args.ph_lo, hi = args.ph_hi;
#ifndef PHMASK
#define PHMASK 0x7ff
#endif
#define IN(k) ((((PHMASK) >> (k)) & 1) && lo <= (k) && (k) < hi)
#define SEAM(k) do { if (IN(k) && IN((k) + 1)) xcd_barrier(bar); } while (0)
    using namespace pg8;
    LAS unsigned char* ring = F.lds;
    const Operand opnone{nullptr, 0, 0}; (void)opnone;

    if (IN(0)) { p0_prologue(F, args); } SEAM(0);
    if (IN(1)) { p1_norm(F, args); } SEAM(1);
    if (IN(2)) {
        const int big = F.bx < 192;
        {
            const Operand A{(const char*)(F.ws + WS_H8), 128, (size_t)HALF * D}, B{(const char*)(F.ws + WS_WIN8), 128, (size_t)HALF * D};
            RangeOrder S{M / BM, 0, big ? 3 * F.bx : 576 + (F.bx - 192), big ? 3 : 1, (size_t)BM * D, (size_t)BM * D};
            EpiProj E{(f16*)(F.ws + WS_U16), (f16*)(F.ws + WS_Q16), (f16*)(F.ws + WS_K16), (f16*)(F.ws + WS_V16), (float*)(F.ws + WS_QI32), (float*)(F.ws + WS_KW32), 1.0f / (HA8_S * WU8_S)};
            gemm_phase<false, true>(ring, A, B, D / 128, RowMajorOff{D / 2}, RowMajorOff{D / 2}, S, E);
        }
        {
            const Operand A{(const char*)(F.ws + WS_X16), 128, (size_t)HALF * D * 2}, B{(const char*)(F.ws + WS_WIN) + (size_t)2560 * D * 2, 128, (size_t)HALF * D * 2};
            RangeOrder S{M / BM, 10, big ? F.bx : 192 + 2 * (F.bx - 192), big ? 1 : 2, (size_t)BM * D * 2, (size_t)BM * D * 2};
            EpiProj E{(f16*)(F.ws + WS_U16), (f16*)(F.ws + WS_Q16), (f16*)(F.ws + WS_K16), (f16*)(F.ws + WS_V16), (float*)(F.ws + WS_QI32), (float*)(F.ws + WS_KW32), 0.f};
            gemm_phase(ring, A, B, D / BK, RowMajorOff{D}, RowMajorOff{D}, S, E);
        }
    } SEAM(2);
    if (IN(3)) {
        p3_post<0>(F, args);
        __syncthreads();
        const Operand A{(const char*)(F.ws + WS_U16), (size_t)4 * D_SSM * 2, (size_t)HALF * CT * D_SSM * 2}, B{(const char*)(F.ws + WS_T1), 128, (size_t)HALF * 512 * 2};
        GroupOrder S{2, 3, NG, F.G, F.bx, (size_t)BM * CT * D_SSM * 2, (size_t)BM * 512 * 2, (size_t)SG * 2, (size_t)768 * 512 * 2};
        EpiSsm1 E{(f16*)(F.ws + WS_YIN), (float*)(F.ws + WS_E32)};
        gemm_phase<false, false, false, true>(ring, A, B, 512 / BK, UStrideOff{}, RowMajorOff{512}, S, E);
    } SEAM(3);
    if (IN(4)) { p4_scan(F); p4_indexer<0>(F);
    }
    if (IN(4) && IN(5)) {
        if (F.tid == 0) { unsigned* ctr = (unsigned*)(F.ws + WS_CTL) + CW_SCAN; XB_SPIN(xb_ld(ctr) < 128u, ctl + CW_BAR); __builtin_amdgcn_fence(__ATOMIC_ACQUIRE, "agent"); asm volatile("s_waitcnt vmcnt(0)" ::: "memory"); }
        __syncthreads();
    }
    if (IN(5)) {
        const Operand A{(const char*)(F.ws + WS_SPREV), 128, (size_t)HALF * 256 * 2}, B{(const char*)(F.ws + WS_WY), 128, (size_t)HALF * 256 * 2};
        EpiSsm2 E{(f16*)(F.ws + WS_YIN), (const f16*)(F.ws + WS_U16), args.in[14]};
        if (F.tid == 0) MISC[20] = xb_add(ctl + CW_G2Q, 1u);
        __syncthreads();
        { const unsigned id = MISC[20];
          if (id < 256u) { OneUnit2 S{(int)id, (size_t)BM * 256 * 2, (size_t)BM * 256 * 2, (size_t)512 * 256 * 2, (size_t)512 * 256 * 2}; gemm_phase(ring, A, B, 256 / BK, RowMajorOff{256}, RowMajorOff{256}, S, E); } }
        if (F.tid == 0) MISC[21] = xb_add(ctl + CW_G2Q, 1u);
        __syncthreads();
        { const unsigned id = MISC[21];
          if (id < 256u) { OneUnit2 S{(int)id, (size_t)BM * 256 * 2, (size_t)BM * 256 * 2, (size_t)512 * 256 * 2, (size_t)512 * 256 * 2}; gemm_phase(ring, A, B, 256 / BK, RowMajorOff{256}, RowMajorOff{256}, S, E); } }
    } SEAM(5);
    if (IN(6)) {
        const Operand A{(const char*)(F.ws + WS_YIN), 128, (size_t)HALF * D_SSM * 2}, B{(const char*)(F.ws + WS_WGLU), 128, (size_t)HALF * D_SSM * 2};
        RectOrder S; S.init(M, D_SSM, F.G, F.bx, (size_t)BM * D_SSM * 2, (size_t)BM * D_SSM * 2);
        EpiGlu E{(const f16*)(F.ws + WS_YIN), (f16*)(F.ws + WS_MIX), args.in[16], (float*)(F.ws + WS_CTL) + CW_RSS};
        gemm_phase(ring, A, B, D_SSM / BK, RowMajorOff{D_SSM}, RowMajorOff{D_SSM}, S, E);
    }
    if (IN(7)) { p7_attn<0>(F, args);
    } SEAM(7);
    if (IN(8)) {
        const Operand A{(const char*)(F.ws + WS_MIX), 128, (size_t)HALF * D * 2}, B{(const char*)(F.ws + WS_WOUT), 128, (size_t)HALF * D * 2};
        RectOrderK2 S; S.base.init(M, D, F.G, F.bx, (size_t)BM * D * 2, (size_t)BM * D * 2); S.khalf_bytes = (size_t)D_SSM * 2;
        EpiOut E{args.in[0], (f16*)(F.ws + WS_X1H), (f16*)(F.ws + WS_X16), (const float*)(F.ws + WS_SMALL) + SM_VEC, (float*)(F.ws + WS_CTL) + CW_RSX, (const float*)(F.ws + WS_CTL) + CW_RSS, (const float*)(F.ws + WS_CTL) + CW_RSA2};
        gemm_phase<true>(ring, A, B, D_SSM / BK, RowMajorOff{D}, RowMajorOff{D}, S, E);
    } SEAM(8);
    if (IN(9)) {
        const Operand A{(const char*)(F.ws + WS_X16), 128, (size_t)HALF * D}, B{(const char*)(F.ws + WS_WUP), 128, (size_t)8 * D};
        RectOrder S; S.init(M, D_FF, F.G, F.bx, (size_t)BM * D, (size_t)BM * D);
        EpiUp E{(f16*)(F.ws + WS_HFF), (const float*)(F.ws + WS_SMALL) + SM_BIAS2, (const float*)(F.ws + WS_CTL) + CW_RSX};
        gemm_phase<false, true, true>(ring, A, B, D / 128, RowMajorOff{D / 2}, RowMajorOff{D / 2}, S, E);
    } SEAM(9);
    if (IN(10)) {
        const Operand A{(const char*)(F.ws + WS_HFF), 128, (size_t)HALF * D_FF}, B{(const char*)(F.ws + WS_WDN), 128, (size_t)HALF * D_FF};
        RectOrder S; S.init(M, D, F.G, F.bx, (size_t)BM * D_FF, (size_t)BM * D_FF);
        EpiDown E{args.out, (const f16*)(F.ws + WS_X1H), (const float*)(F.ws + WS_SMALL) + SM_VEC, (const float*)(F.ws + WS_SMALL) + SM_CSUM};
        gemm_phase<false, true>(ring, A, B, D_FF / 128, RowMajorOff{D_FF / 2}, RowMajorOff{D_FF / 2}, S, E);
    }
#undef IN
#undef SEAM
}

extern "C" void kernel_launch(void* const* d_in, const int* in_sizes, int n_in, void* d_out, int out_size, void* d_ws, size_t ws_size, hipStream_t stream) {
    static int grid = 0;
    if (grid == 0) {
        if (n_in != 25 || out_size != M * D || ws_size < WS_END) { fprintf(stderr, "kernel_launch: unexpected shapes (n_in %d, out %d, ws %zu)\n", n_in, out_size, ws_size); grid = -1; return; }
        int dev = 0, cus = 0;
        if (hipGetDevice(&dev) != hipSuccess || hipDeviceGetAttribute(&cus, hipDeviceAttributeMultiprocessorCount, dev) != hipSuccess) { grid = -1; return; }
        if (hipFuncSetAttribute((const void*)hymba_fwd, hipFuncAttributeMaxDynamicSharedMemorySize, LDS_BYTES) != hipSuccess) { fprintf(stderr, "kernel_launch: hipFuncSetAttribute failed\n"); grid = -1; return; }
        int per_cu = 0;
        if (hipOccupancyMaxActiveBlocksPerMultiprocessor(&per_cu, (const void*)hymba_fwd, NWAVES * 64, LDS_BYTES) != hipSuccess || per_cu < 1) fprintf(stderr, "kernel_launch: occupancy query says %d\n", per_cu);
        (void)hipGetLastError();
        grid = cus;
        if (grid != 256) { fprintf(stderr, "kernel_launch: built for 256 CUs, found %d\n", cus); grid = -1; return; }
    }
    if (grid < 0) return;
    if (hipMemsetAsync((char*)d_ws + WS_CTL, 0, CTL_ZERO_BYTES, stream) != hipSuccess) return;
    Args a{};
    for (int i = 0; i < 25; ++i) a.in[i] = (const float*)d_in[i];
    a.out = (float*)d_out; a.ws = (unsigned char*)d_ws;
    for (int i = 0; i < 16; ++i) a.inv16[i] = (double)(float)std::pow(500000.0, -(double)i / 16.0);
    for (int i = 0; i < 8; ++i) a.inv8[i] = (double)(float)std::pow(500000.0, -(double)i / 8.0);
    if (MK_N_LAUNCHES == 1) { a.ph_lo = 0; a.ph_hi = NPH; hipLaunchKernelGGL(hymba_fwd, dim3(grid), dim3(NWAVES * 64), LDS_BYTES, stream, a); }
    else for (int p = 0; p < NPH; ++p) { a.ph_lo = p; a.ph_hi = p + 1; hipLaunchKernelGGL(hymba_fwd, dim3(grid), dim3(NWAVES * 64), LDS_BYTES, stream, a);
    }
}
```

```cpp
#include <hip/hip_runtime.h>
#include <cstdio>
#include <cmath>

#ifndef MK_N_LAUNCHES
#define MK_N_LAUNCHES 1
#endif

#define LAS __attribute__((address_space(3)))
#define GAS __attribute__((address_space(1)))
typedef _Float16 f16;
typedef _Float16 half8 __attribute__((ext_vector_type(8)));
typedef _Float16 half4 __attribute__((ext_vector_type(4)));
typedef _Float16 half2v __attribute__((ext_vector_type(2)));
typedef float f32x2 __attribute__((ext_vector_type(2)));
typedef float f32x4 __attribute__((ext_vector_type(4)));
typedef float f32x16 __attribute__((ext_vector_type(16)));
typedef unsigned u32x2 __attribute__((ext_vector_type(2)));
typedef unsigned u32x4 __attribute__((ext_vector_type(4)));
typedef unsigned short u16;
typedef int i32x4 __attribute__((ext_vector_type(4)));
constexpr float QK8_S = 127.0f / 6.0f;
constexpr float V8_S = 127.0f / 8.0f;
constexpr float HA8_S = 127.0f / 6.5f;
constexpr float XA8_S = 127.0f / 6.5f;
constexpr float WU8_S = 127.0f / 0.105f;
constexpr float H8_S = 255.0f / 24.0f;
constexpr float WD8_S = 127.0f / 0.0525f;

constexpr int D = 2048, BATCH = 2, SEQ = 8192, M = BATCH * SEQ;
constexpr int D_SSM = 1024, NG = 64, SG = 16, SP = 64, D_ATTN = 1024, HD = 128, NH = 8, NKV = 2;
constexpr int NIH = 16, ID = 64, TOPK = 256, D_FF = 8192, N_MOD = 6;
constexpr int D_IN = 3664, D_INP = 3840;
constexpr int CT = 32, NCH = SEQ / CT;
constexpr float EPS = 1e-6f;
constexpr float WSC = 64.f, WSC_INV = 1.f / 64.f;
constexpr float TSC = 1024.f, TSC_INV = 1.f / 1024.f;

constexpr size_t MiB = 1u << 20;
constexpr size_t WS_CTL = 0, CTL_ZERO_BYTES = 1 * MiB;
constexpr size_t WS_SMALL = 1 * MiB;
constexpr size_t WS_WUP = 2 * MiB, WS_WDN = 34 * MiB, WS_X16 = 66 * MiB;
constexpr size_t WS_WIN = 130 * MiB, WS_WGLU = 145 * MiB, WS_WOUT = 147 * MiB, WS_T1 = 155 * MiB, WS_WY = 203 * MiB;
constexpr size_t WS_U16 = 219 * MiB, WS_Q16 = 251 * MiB, WS_K16 = 283 * MiB, WS_V16 = 291 * MiB, WS_QI32 = 299 * MiB, WS_KW32 = 363 * MiB;
constexpr size_t WS_KI16 = 379 * MiB, WS_WI32 = 381 * MiB, WS_YIN = 382 * MiB, WS_E32 = 414 * MiB, WS_SPREV = 430 * MiB, WS_SEL = 446 * MiB;
constexpr size_t WS_H8 = WS_YIN;
constexpr size_t WS_WIN8 = WS_SPREV;
constexpr size_t WS_MIX = WS_QI32;
constexpr size_t WS_HFF = 130 * MiB;
constexpr size_t WS_X1H = 386 * MiB;
constexpr size_t WS_K8 = WS_X16, WS_V8 = 291 * MiB  ;
constexpr size_t WS_END = 454 * MiB;
constexpr int CW_BAR = 4096;
constexpr int CW_QH = 8192;
constexpr int CW_ATT = 8256;
constexpr int CW_G1Q = 8576;
constexpr int CW_G2Q = 8512;
constexpr int CW_SCAN = 8208;
constexpr int CW_RSS = 32768;
constexpr int CW_RSX = 32768 + 16384;
constexpr int CW_RSA2 = CW_RSX + 16384;
static_assert((CW_RSA2 + 32768) * 4 <= (int)CTL_ZERO_BYTES, "ctl");
constexpr int SM_MODP = 0;
constexpr int SM_VEC = 8 * 2 * 12288;
constexpr int SM_BIAS2 = SM_VEC + 2 * 6 * 2048;
constexpr int SM_LAMT = SM_BIAS2 + 2 * 8192;
constexpr int SM_CSUM = SM_LAMT + 64 * 64 * 2;
static_assert((SM_CSUM + 2048) * 4 <= (int)MiB, "small");

constexpr int RING_BYTES = 131072;
constexpr int MISC_OFF = 159744;
constexpr int LDS_BYTES = MISC_OFF + 256;

#define RLX_AGENT __ATOMIC_RELAXED, __HIP_MEMORY_SCOPE_AGENT
#define LDS_WAIT() asm volatile("s_waitcnt lgkmcnt(0)" ::: "memory")
#define VM_WAIT() asm volatile("s_waitcnt vmcnt(0)" ::: "memory")

#define XB_TMO      128
#define XB_XCNT(j)  (256  + 64 * (j))
#define XB_XSUB(j)  (1280 + 64 * (j))
#define XB_XGEN(j)  (2304 + 64 * (j))
#define XB_TOP      3328
#define XB_TOPGEN   3392
#define XCD_BAR_WORDS 3456
#define XB_SPIN_CAP (1u << 22)
__device__ __forceinline__ unsigned xb_ld(unsigned* p)              { return __hip_atomic_load(p, __ATOMIC_RELAXED, __HIP_MEMORY_SCOPE_AGENT); }
__device__ __forceinline__ unsigned xb_add(unsigned* p, unsigned v) { return __hip_atomic_fetch_add(p, v, __ATOMIC_RELAXED, __HIP_MEMORY_SCOPE_AGENT); }
__device__ __forceinline__ unsigned xb_xcc_id() { return (unsigned)__builtin_amdgcn_s_getreg((3 << 11) | 20) & 0xFu; }
#define XB_SPIN(cond, bar) do { unsigned _sp = 0; while (cond) { __builtin_amdgcn_s_sleep(1); \
    if ((++_sp & 255u) == 0u) { if (xb_ld(&(bar)[XB_TMO])) break; if (_sp > XB_SPIN_CAP) { atomicAdd(&(bar)[XB_TMO], 1u); break; } } } } while (0)
struct XcdBarrier { unsigned* bar; unsigned x; volatile LAS unsigned* st; };
__device__ __forceinline__ XcdBarrier xcd_barrier_post(unsigned* bar, volatile LAS unsigned* st) {
    XcdBarrier b; b.bar = bar; b.x = xb_xcc_id(); b.st = st;
    if (threadIdx.x == 0) (void)xb_add(&bar[XB_XCNT(b.x)], 1u);
    return b;
}
__device__ __forceinline__ void xcd_barrier_complete(unsigned* bar, unsigned x, unsigned& nloc, unsigned& nx) {
    const unsigned G = gridDim.x * gridDim.y * gridDim.z;
    unsigned sum, cnt, mine, sp = 0u;
    for (;;) {
        sum = 0u; cnt = 0u; mine = 0u;
#pragma unroll
        for (unsigned j = 0; j < 16; ++j) { const unsigned c = xb_ld(&bar[XB_XCNT(j)]); sum += c; cnt += (c > 0u) ? 1u : 0u; mine = (j == x) ? c : mine; }
        if (sum == G) break;
        __builtin_amdgcn_s_sleep(1);
        if ((++sp & 255u) == 0u) { if (xb_ld(&bar[XB_TMO])) break; if (sp > XB_SPIN_CAP) { atomicAdd(&bar[XB_TMO], 1u); break; } }
    }
    nloc = mine > 0u ? mine : 1u; nx = cnt > 0u ? cnt : 1u;
}
__device__ __forceinline__ void xcd_barrier(const XcdBarrier& b) {
    asm volatile("s_waitcnt vmcnt(0)" ::: "memory");
    __syncthreads();
    if (threadIdx.x == 0) {
        unsigned* bar = b.bar;
        __builtin_amdgcn_s_waitcnt(0);
        unsigned nloc = b.st[0], nx = b.st[1];
        if (nloc == 0u) { xcd_barrier_complete(bar, b.x, nloc, nx); b.st[0] = nloc; b.st[1] = nx; }
        const unsigned old = xb_add(&bar[XB_XSUB(b.x)], 1u);
        const unsigned gen = old / nloc;
        if (old + 1u == (gen + 1u) * nloc) {
            __builtin_amdgcn_fence(__ATOMIC_RELEASE, "agent");
            asm volatile("s_waitcnt vmcnt(0)" ::: "memory");
            const unsigned og = xb_add(&bar[XB_TOP], 1u);
            const unsigned tg = og / nx;
            if (og + 1u == (tg + 1u) * nx) xb_add(&bar[XB_TOPGEN], 1u);
            else XB_SPIN(xb_ld(&bar[XB_TOPGEN]) == tg, bar);
            __builtin_amdgcn_fence(__ATOMIC_ACQUIRE, "agent");
            xb_add(&bar[XB_XGEN(b.x)], 1u);
            asm volatile("s_waitcnt vmcnt(0)" ::: "memory");
        } else {
            XB_SPIN(xb_ld(&bar[XB_XGEN(b.x)]) == gen, bar);
            __builtin_amdgcn_fence(__ATOMIC_ACQUIRE, "agent");
            asm volatile("s_waitcnt vmcnt(0)" ::: "memory");
        }
    }
    __syncthreads();
}

__device__ __forceinline__ float wave_sum(float v) {
#pragma unroll
    for (int o = 1; o < 64; o <<= 1) v += __shfl_xor(v, o);
    return v;
}
__device__ __forceinline__ half2v u2h(const unsigned x) { return __builtin_bit_cast(half2v, x); }
__device__ __forceinline__ unsigned pkh(float a, float b) { half2v h = {(f16)a, (f16)b}; return __builtin_bit_cast(unsigned, h); }
__device__ __forceinline__ u32x4 pk8(const f32x4 a, const f32x4 b) { u32x4 w; w.x = pkh(a[0], a[1]); w.y = pkh(a[2], a[3]); w.z = pkh(b[0], b[1]); w.w = pkh(b[2], b[3]); return w; }
__device__ __forceinline__ void unpk8(const u32x4 w, float (&o)[8]) {
    const half8 h = __builtin_bit_cast(half8, w);
#pragma unroll
    for (int i = 0; i < 8; ++i) o[i] = (float)h[i];
}
__device__ __forceinline__ unsigned pk4i8(float a, float b, float c, float d, const float S = QK8_S) {
    const int ia = (int)__builtin_rintf(fminf(fmaxf(a * S, -127.f), 127.f)), ib = (int)__builtin_rintf(fminf(fmaxf(b * S, -127.f), 127.f));
    const int ic = (int)__builtin_rintf(fminf(fmaxf(c * S, -127.f), 127.f)), id = (int)__builtin_rintf(fminf(fmaxf(d * S, -127.f), 127.f));
    return (unsigned)(ia & 255) | ((unsigned)(ib & 255) << 8) | ((unsigned)(ic & 255) << 16) | ((unsigned)(id & 255) << 24);
}
__device__ __forceinline__ unsigned pk4u8m128(float a, float b, float c, float d, const float S) {
    unsigned w = 0u;
    w = __builtin_amdgcn_cvt_pk_u8_f32(a * S, 0u, w); w = __builtin_amdgcn_cvt_pk_u8_f32(b * S, 1u, w); w = __builtin_amdgcn_cvt_pk_u8_f32(c * S, 2u, w); w = __builtin_amdgcn_cvt_pk_u8_f32(d * S, 3u, w);
    return w ^ 0x80808080u;
}
__device__ __forceinline__ float sigmoidf_(float x) { return 1.0f / (1.0f + __expf(-x)); }
__device__ __forceinline__ float gelu_tanh(float y) { const float z = 0.7978845608028654f * (y + 0.044715f * y * y * y); const float t = 1.0f - 2.0f / (1.0f + __expf(2.0f * z)); return 0.5f * y * (1.0f + t); }
__device__ __forceinline__ double dexp(double x) {
    const double y = x * (1.0 / 1024.0); double s = 1.0 + y * (1.0 + y * (0.5 + y * ((1.0 / 6.0) + y * ((1.0 / 24.0) + y * ((1.0 / 120.0) + y * ((1.0 / 720.0) + y * (1.0 / 5040.0)))))));
#pragma unroll 1
    for (int i = 0; i < 10; ++i) s *= s;
    return s;
}
__device__ __forceinline__ void dsincos(double a, double& sn, double& cs) {
    const double TWO_PI = 6.283185307179586476925286766559;
    const double k = rint(a * (1.0 / TWO_PI)); double r = a - k * TWO_PI;
    r *= 0.125;
    const double r2 = r * r;
    double c = 1.0 + r2 * (-1.0 / 2.0 + r2 * (1.0 / 24.0 + r2 * (-1.0 / 720.0 + r2 * (1.0 / 40320.0 + r2 * (-1.0 / 3628800.0 + r2 * (1.0 / 479001600.0 + r2 * (-1.0 / 87178291200.0)))))));
    double s = r * (1.0 + r2 * (-1.0 / 6.0 + r2 * (1.0 / 120.0 + r2 * (-1.0 / 5040.0 + r2 * (1.0 / 362880.0 + r2 * (-1.0 / 39916800.0 + r2 * (1.0 / 6227020800.0 + r2 * (-1.0 / 1307674368000.0))))))));
#pragma unroll 1
    for (int i = 0; i < 3; ++i) { const double s2 = 2.0 * s * c, c2 = 1.0 - 2.0 * s * s; s = s2; c = c2; }
    sn = s; cs = c;
}

namespace pg8 {
constexpr int BM = 256, BK = 64, HALF = 128, HTB = HALF * BK * 2, STAGE_BYTES = 8 * HTB, NXCD = 8, WGM = 8;
__device__ __forceinline__ int lds_byte(int r, int c) { const int st = (r >> 4) * 2 + (c >> 5), rr = r & 15, cc = c & 31, ob = rr * 64 + cc * 2; return st * 1024 + (ob ^ (((ob >> 9) & 1) << 5)); }
__device__ __forceinline__ void stage_rc(int b, int& R, int& C) { const int st = b / 1024, sb = b % 1024, swz = sb ^ (((sb >> 9) & 1) << 5); R = (st >> 1) * 16 + swz / 64; C = (st & 1) * 32 + (swz % 64) / 2; }
__device__ __forceinline__ int perm32(int rho) { const int n = rho >> 4, i = rho & 15; return 8 * (i >> 2) + 4 * n + (i & 3); }

struct Unit { int pm, pn, g, kh, half; size_t offA, offB; };
struct Operand { const char* base; size_t kstep, hstep; };
struct RowMajorOff { int K; __device__ __forceinline__ unsigned operator()(int R, int C) const { return (unsigned)(R * K + C) * 2u; } };
struct UStrideOff { __device__ __forceinline__ unsigned operator()(int R, int C) const { return (unsigned)(((R * CT + (C >> 4)) * D_SSM + (C & 15)) * 2); } };

struct RectOrder {
    int nM, nN, nwg, G, c; size_t tA, tB;
    __device__ __forceinline__ void init(int Mr, int Nr, int G_, int c_, size_t tA_, size_t tB_) { nM = Mr / BM; nN = Nr / BM; nwg = nM * nN; G = G_; c = c_; tA = tA_; tB = tB_; }
    __device__ __forceinline__ bool next(int i, Unit& u) const {
        const long L = (long)i * G + c; if (L >= nwg) return false;
        int wgid = (int)L; { const int q = nwg / NXCD, r = nwg % NXCD, xcd = wgid % NXCD, off = wgid / NXCD; wgid = (xcd < r ? xcd * (q + 1) : r * (q + 1) + (xcd - r) * q) + off; }
        const int nig = WGM * nN, gid = wgid / nig, fm = gid * WGM, gsz = (nM - fm) < WGM ? (nM - fm) : WGM;
        u.pm = fm + ((wgid % nig) % gsz); u.pn = (wgid % nig) / gsz; u.g = 0; u.kh = 1; u.half = 0; u.offA = (size_t)u.pm * tA; u.offB = (size_t)u.pn * tB; return true;
    }
};
struct RectOrderK2 { RectOrder base; size_t khalf_bytes;
    __device__ __forceinline__ bool next(int i, Unit& u) const { if (!base.next(i >> 1, u)) return false; u.kh = i & 1; if (u.kh) { u.offA += khalf_bytes; u.offB += khalf_bytes; } return true; } };
struct RangeOrder { int nM, pn0, first, cnt; size_t tA, tB;
    __device__ __forceinline__ bool next(int i, Unit& u) const { if (i >= cnt) return false; const int L = first + i; u.pm = L % nM; u.pn = pn0 + L / nM; u.g = 0; u.kh = 1; u.half = 0; u.offA = (size_t)u.pm * tA; u.offB = (size_t)(L / nM) * tB; return true; } };
struct OneUnit1 { int id; size_t tA, tB, gA, gB;
    __device__ __forceinline__ bool next(int i, Unit& u) const { if (i > 0) return false; int g, pm, pn;
        if (id < 256) { g = id >> 2; pm = id & 1; pn = (id >> 1) & 1; } else { const int e = id - 256; g = e >> 1; pm = e & 1; pn = 2; }
        u.g = g; u.kh = 1; u.half = pn == 2; u.pm = pm; u.pn = pn; u.offA = (size_t)g * gA + (size_t)pm * tA; u.offB = (size_t)g * gB + (size_t)pn * tB; return true; } };
struct OneUnit2 { int id; size_t tA, tB, gA, gB;
    __device__ __forceinline__ bool next(int i, Unit& u) const { if (i > 0) return false; const int g = id >> 2, r = id & 3; u.g = g; u.kh = 1; u.half = 0; u.pm = r & 1; u.pn = r >> 1;
        u.offA = (size_t)g * gA + (size_t)u.pm * tA; u.offB = (size_t)g * gB + (size_t)u.pn * tB; return true; } };
struct GroupOrder {
    int nM, nN, ng, G, c; size_t tA, tB, gA, gB;
    __device__ __forceinline__ bool next(int i, Unit& u) const {
        const long L = (long)i * G + c; if (L >= (long)ng * nM * nN) return false;
        int g, pm, pn;
        if (nN == 3) {
            const int nfull = ng * nM * 2;
            if (L < nfull) { g = (int)(L / (nM * 2)); const int r = (int)(L % (nM * 2)); pm = r % nM; pn = r / nM; } else { const int e = (int)(L - nfull); g = e / nM; pm = e % nM; pn = 2; }
        } else { const int per = nM * nN; g = (int)(L / per); const int r = (int)(L % per); pm = r % nM; pn = r / nM; }
        u.g = g; u.kh = 1; u.half = (nN == 3 && pn == 2) ? 1 : 0; u.pm = pm; u.pn = pn; u.offA = (size_t)g * gA + (size_t)pm * tA; u.offB = (size_t)g * gB + (size_t)pn * tB; return true;
    }
};

template <bool MID = false, bool I8 = false, bool WIDE = false, bool HALFN = false, class Epi, class Sched, class AOff, class BOff>
__device__ __forceinline__ void gemm_phase(LAS unsigned char* lds, const Operand opA, const Operand opB, const int nt, const AOff aoffF, const BOff boffF, const Sched& S, const Epi& E) {
    const int tid = threadIdx.x, wid = __builtin_amdgcn_readfirstlane(tid >> 6), lane = tid & 63, wr = wid >> 2, wc = wid & 3, fr = lane & 15, fq = lane >> 4;
    unsigned voffA[2], voffB[2];
#pragma unroll
    for (int i = 0; i < 2; ++i) { int R, C; stage_rc(tid * 16 + i * 8192, R, C); const int Rb = (R & ~31) + perm32(R & 31);
        voffA[i] = aoffF(R, C); voffB[i] = boffF(WIDE ? 16 * (Rb >> 3) + (Rb & 7) : Rb, C); }
    const size_t kA = opA.kstep, hA = opA.hstep, kB = opB.kstep, hB = opB.hstep;
    const unsigned ldsw = (unsigned)wid * 1024u;
    const int aoff = lds_byte(wr * 64 + fr, fq * 8), boff = lds_byte(wc * 32 + fr, fq * 8);
#define PG8_SA(b, h) (((b) * 2 + (h)) * HTB)
#define PG8_SB(b, h) ((4 + (b) * 2 + (h)) * HTB)
#define PG8_STAGE(bufoff, gbase, voff) do { _Pragma("unroll") for (int _i = 0; _i < 2; ++_i) \
        __builtin_amdgcn_global_load_lds((const unsigned*)((const char*)(gbase) + (voff)[_i]), (LAS unsigned*)(lds + (bufoff) + ldsw + _i * 8192), 16, 0, 0); } while (0)
#define PG8_LDA(dst, b, h) do { _Pragma("unroll") for (int m = 0; m < 4; ++m) _Pragma("unroll") for (int k = 0; k < 2; ++k) dst[m][k] = *(const LAS half8*)(lds + PG8_SA(b, h) + aoff + m * 2048 + k * 1024); } while (0)
#define PG8_LDB(dst, b, h) do { _Pragma("unroll") for (int n = 0; n < 2; ++n) _Pragma("unroll") for (int k = 0; k < 2; ++k) dst[n][k] = *(const LAS half8*)(lds + PG8_SB(b, h) + boff + n * 2048 + k * 1024); } while (0)
#define PG8_MMA(ai, bj, At, Bt) do { __builtin_amdgcn_s_setprio(1); _Pragma("unroll") for (int m = 0; m < 4; ++m) _Pragma("unroll") for (int n = 0; n < 2; ++n) _Pragma("unroll") for (int k = 0; k < 2; ++k) { \
        if constexpr (I8) acc[ai][bj][m][n] = __builtin_bit_cast(f32x4, __builtin_amdgcn_mfma_i32_16x16x64_i8(__builtin_bit_cast(i32x4, Bt[n][k]), __builtin_bit_cast(i32x4, At[m][k]), __builtin_bit_cast(i32x4, acc[ai][bj][m][n]), 0, 0, 0)); \
        else acc[ai][bj][m][n] = __builtin_amdgcn_mfma_f32_16x16x32_f16(Bt[n][k], At[m][k], acc[ai][bj][m][n], 0, 0, 0); } __builtin_amdgcn_s_setprio(0); } while (0)
#define PG8_WAIT_V(n) asm volatile("s_waitcnt vmcnt(" #n ")" ::: "memory")
#define PG8_WAIT_L(n) asm volatile("s_waitcnt lgkmcnt(" #n ")" ::: "memory")
#define PG8_BAR __builtin_amdgcn_s_barrier()
#define PG8_SCHED __builtin_amdgcn_sched_barrier(0)
    Unit cur, nxt; int ui = 0;
    if (!S.next(0, cur)) return;
    f32x4 acc[2][2][4][2];
#pragma unroll
    for (int a = 0; a < 2; ++a)
#pragma unroll
        for (int b = 0; b < 2; ++b)
#pragma unroll
            for (int m = 0; m < 4; ++m)
#pragma unroll
                for (int n = 0; n < 2; ++n) acc[a][b][m][n] = (f32x4){0.f, 0.f, 0.f, 0.f};
    half8 At[4][2], B0[2][2], B1[2][2];
    const char* cA = opA.base + cur.offA; const char* cB = opB.base + cur.offB;
    PG8_STAGE(PG8_SB(0, 0), cB, voffB); PG8_STAGE(PG8_SB(0, 1), cB + hB, voffB); PG8_STAGE(PG8_SA(0, 0), cA, voffA); PG8_STAGE(PG8_SA(0, 1), cA + hA, voffA);
    if (wr == 1) PG8_BAR;
    PG8_WAIT_V(2); PG8_BAR;
    PG8_STAGE(PG8_SB(1, 0), cB + kB, voffB); PG8_STAGE(PG8_SA(1, 0), cA + kA, voffA); PG8_STAGE(PG8_SB(1, 1), cB + hB + kB, voffB);
    PG8_WAIT_V(6); PG8_BAR;
    for (;;) {
        const bool has_next = S.next(ui + 1, nxt);
        const char* nA = has_next ? opA.base + nxt.offA : cA; const char* nB = has_next ? opB.base + nxt.offB : cB;
        for (int t = 0; t < nt; t += 2) {
            const bool last = (t == nt - 2);
            const char* a1 = cA + (size_t)(t + 1) * kA;
            const char* a2 = last ? nA : cA + (size_t)(t + 2) * kA; const char* b2 = last ? nB : cB + (size_t)(t + 2) * kB;
            const char* a3 = a2 + kA; const char* b3 = b2 + kB;
            PG8_LDB(B0, 0, 0); PG8_LDB(B1, 0, 1); PG8_SCHED; PG8_LDA(At, 0, 0); PG8_STAGE(PG8_SA(1, 1), a1 + hA, voffA);
            PG8_WAIT_V(8); PG8_WAIT_L(0); PG8_BAR; PG8_MMA(0, 0, At, B0); if (!HALFN || !cur.half) PG8_MMA(0, 1, At, B1); PG8_BAR; PG8_SCHED;
            PG8_LDA(At, 0, 1); PG8_STAGE(PG8_SB(0, 0), b2, voffB); PG8_STAGE(PG8_SB(0, 1), b2 + hB, voffB); PG8_STAGE(PG8_SA(0, 0), a2, voffA);
            PG8_WAIT_V(8); PG8_WAIT_L(0); PG8_BAR; PG8_MMA(1, 0, At, B0); if (!HALFN || !cur.half) PG8_MMA(1, 1, At, B1); PG8_BAR; PG8_SCHED;
            PG8_LDB(B0, 1, 0); PG8_LDB(B1, 1, 1); PG8_SCHED; PG8_LDA(At, 1, 0); PG8_STAGE(PG8_SA(0, 1), a2 + hA, voffA);
            PG8_WAIT_V(8); PG8_WAIT_L(0); PG8_BAR; PG8_MMA(0, 0, At, B0); if (!HALFN || !cur.half) PG8_MMA(0, 1, At, B1); PG8_BAR; PG8_SCHED;
            PG8_LDA(At, 1, 1); PG8_STAGE(PG8_SB(1, 0), b3, voffB); PG8_STAGE(PG8_SB(1, 1), b3 + hB, voffB); PG8_STAGE(PG8_SA(1, 0), a3, voffA);
            PG8_WAIT_V(8); PG8_WAIT_L(0); PG8_BAR; PG8_MMA(1, 0, At, B0); if (!HALFN || !cur.half) PG8_MMA(1, 1, At, B1); PG8_BAR; PG8_SCHED;
        }
        if (wr == 0) PG8_BAR;
        bool carry = false;
        if constexpr (MID) { if (cur.kh == 0) { E.mid(acc, cur, wr, wc, fr, fq); carry = true; } }
        if (!carry) E(acc, cur, wr, wc, fr, fq);
        if (!has_next) break;
        if (!carry) {
#pragma unroll
        for (int a = 0; a < 2; ++a)
#pragma unroll
            for (int b = 0; b < 2; ++b)
#pragma unroll
                for (int m = 0; m < 4; ++m)
#pragma unroll
                    for (int n = 0; n < 2; ++n) acc[a][b][m][n] = (f32x4){0.f, 0.f, 0.f, 0.f}; }
        cur = nxt; cA = nA; cB = nB; ++ui;
        if (wr == 1) PG8_BAR;
    }
    PG8_WAIT_V(0);
    PG8_BAR;
#undef PG8_SA
#undef PG8_SB
#undef PG8_STAGE
#undef PG8_LDA
#undef PG8_LDB
#undef PG8_MMA
#undef PG8_WAIT_V
#undef PG8_WAIT_L
#undef PG8_BAR
#undef PG8_SCHED
}

#define EPI_ROWS(ai, m) for (int ai = 0; ai < 2; ++ai) _Pragma("unroll") for (int m = 0; m < 4; ++m)
struct EpiProj {
    f16 *U16, *Q16, *K16, *V16; float *QI32, *KW32; float sc8;
    __device__ __forceinline__ void operator()(const f32x4 (&acc)[2][2][4][2], const Unit& u, int wr, int wc, int fr, int fq) const {
        const int pn = u.pn; const int row0 = u.pm * BM + wr * 64 + fr, cl = wc * 32 + 8 * fq;
        if (pn < 10) {
            f16* base; int pitch, c0;
            if (pn < 4) { base = U16; pitch = 1024; c0 = pn * 256; } else if (pn < 8) { base = Q16; pitch = 1024; c0 = (pn - 4) * 256; } else if (pn == 8) { base = K16; pitch = 256; c0 = 0; } else { base = V16; pitch = 256; c0 = 0; }
#pragma unroll
            EPI_ROWS(ai, m) { const int r = row0 + ai * HALF + m * 16; f16* rowp = base + (size_t)r * pitch + c0 + cl;
#pragma unroll
                for (int bj = 0; bj < 2; ++bj) { f32x4 v0 = acc[ai][bj][m][0] * WSC_INV, v1 = acc[ai][bj][m][1] * WSC_INV;
                    if (sc8 != 0.f) { const i32x4 a0 = __builtin_bit_cast(i32x4, acc[ai][bj][m][0]), a1 = __builtin_bit_cast(i32x4, acc[ai][bj][m][1]);
                        v0 = (f32x4){(float)a0[0], (float)a0[1], (float)a0[2], (float)a0[3]} * sc8; v1 = (f32x4){(float)a1[0], (float)a1[1], (float)a1[2], (float)a1[3]} * sc8; }
                    if (pn == 9) { u32x2 q; q.x = pk4i8(v0[0], v0[1], v0[2], v0[3], V8_S); q.y = pk4i8(v1[0], v1[1], v1[2], v1[3], V8_S);
                        *(u32x2*)((char*)V16 + ((size_t)bj * M + r) * 128 + cl) = q; }
                    else *(u32x4*)(rowp + bj * HALF) = pk8(v0, v1); } }
        } else {
            if (pn < 14) {
#pragma unroll
                EPI_ROWS(ai, m) { f16* rowp = (f16*)QI32 + (size_t)(row0 + ai * HALF + m * 16) * 2048 + (pn - 10) * 256 + cl;
#pragma unroll
                    for (int bj = 0; bj < 2; ++bj) *(u32x4*)(rowp + bj * HALF) = pk8(acc[ai][bj][m][0] * WSC_INV, acc[ai][bj][m][1] * WSC_INV); }
            } else {
#pragma unroll
                EPI_ROWS(ai, m) { float* rowp = KW32 + (size_t)(row0 + ai * HALF + m * 16) * 256 + cl;
                    { *(f32x4*)(rowp) = acc[ai][0][m][0] * WSC_INV; *(f32x4*)(rowp + 4) = acc[ai][0][m][1] * WSC_INV; } }
            }
        }
    }
};
struct EpiSsm1 {
    f16* YIN; float* E32;
    __device__ __forceinline__ void operator()(const f32x4 (&acc)[2][2][4][2], const Unit& u, int wr, int wc, int fr, int fq) const {
        const int R0 = u.pm * BM + wr * 64 + fr, cl = wc * 32 + 8 * fq;
        if (u.pn < 2) {
#pragma unroll
            EPI_ROWS(ai, m) { const int R = R0 + ai * HALF + m * 16;
#pragma unroll
                for (int bj = 0; bj < 2; ++bj) { const int n = u.pn * 256 + bj * HALF + cl; const int t = n >> 4, h0 = n & 15;
                    *(u32x4*)(YIN + (size_t)(R * CT + t) * D_SSM + u.g * SG + h0) = pk8(acc[ai][bj][m][0] * TSC_INV, acc[ai][bj][m][1] * TSC_INV); } }
        } else {
#pragma unroll
            EPI_ROWS(ai, m) { const int R = R0 + ai * HALF + m * 16; float* rowp = E32 + ((size_t)u.g * 512 + R) * 128 + cl;
                *(f32x4*)(rowp) = acc[ai][0][m][0] * TSC_INV; *(f32x4*)(rowp + 4) = acc[ai][0][m][1] * TSC_INV; }
        }
    }
};
struct EpiSsm2 {
    f16* YIN; const f16* U16; const float* dskip;
    __device__ __forceinline__ void operator()(const f32x4 (&acc)[2][2][4][2], const Unit& u, int wr, int wc, int fr, int fq) const {
        const int R0 = u.pm * BM + wr * 64 + fr, cl = wc * 32 + 8 * fq; const int n0 = u.pn * 256 + cl, h0 = n0 & 15;
        const f32x4 d0 = *(const f32x4*)(dskip + u.g * SG + h0), d1 = *(const f32x4*)(dskip + u.g * SG + h0 + 4);
        unsigned pn = (unsigned)((R0 * CT + (n0 >> 4)) * D_SSM + u.g * SG + h0); asm volatile("" : "+v"(pn));
        u32x4 yn = *(const u32x4*)(YIN + pn), un = *(const u32x4*)(U16 + pn);
#pragma unroll
        for (int st = 0; st < 16; ++st) { const int ri = st >> 1, bj = st & 1, ai = ri >> 2, m = ri & 3;
            const unsigned pc = pn; const u32x4 ycur = yn, ucur = un;
            if (st + 1 < 16) { pn = pc + (bj == 0 ? (unsigned)(8 * D_SSM) : (unsigned)((m == 3 ? (HALF - 48) : 16) * CT * D_SSM - 8 * D_SSM)); asm volatile("" : "+v"(pn)); yn = *(const u32x4*)(YIN + pn); un = *(const u32x4*)(U16 + pn); }
            asm volatile("" ::: "memory");
            float yi[8], uu[8]; unpk8(ycur, yi); unpk8(ucur, uu);
            f32x4 o0, o1;
#pragma unroll
            for (int j = 0; j < 4; ++j) { o0[j] = gelu_tanh(acc[ai][bj][m][0][j] * WSC_INV + yi[j] + d0[j] * uu[j]); o1[j] = gelu_tanh(acc[ai][bj][m][1][j] * WSC_INV + yi[4 + j] + d1[j] * uu[4 + j]); }
            *(u32x4*)(YIN + pc) = pk8(o0, o1);
            asm volatile("" ::: "memory"); }
    }
};
struct EpiGlu {
    const f16* YA; f16* MIX; const float* bglu; float* rss;
    __device__ __forceinline__ void operator()(const f32x4 (&acc)[2][2][4][2], const Unit& u, int wr, int wc, int fr, int fq) const {
        const int row0 = u.pm * BM + wr * 64 + fr, c0 = u.pn * BM + wc * 32 + 8 * fq;
        f32x4 bg[2][2];
#pragma unroll
        for (int bj = 0; bj < 2; ++bj) { bg[bj][0] = *(const f32x4*)(bglu + c0 + bj * HALF); bg[bj][1] = *(const f32x4*)(bglu + c0 + bj * HALF + 4); }
        u32x4 yn[2];
#define EG_LOAD(ri_) do { const int r_ = row0 + ((ri_) >> 2) * HALF + ((ri_) & 3) * 16; yn[0] = *(const u32x4*)(YA + (size_t)r_ * D_SSM + c0); yn[1] = *(const u32x4*)(YA + (size_t)r_ * D_SSM + c0 + HALF); } while (0)
        EG_LOAD(0);
#pragma unroll
        for (int ri = 0; ri < 8; ++ri) { const int ai = ri >> 2, m = ri & 3; const int r = row0 + ai * HALF + m * 16; float ss = 0.f;
            const u32x4 yc0 = yn[0], yc1 = yn[1];
            if (ri + 1 < 8) EG_LOAD(ri + 1);
            asm volatile("" ::: "memory");
#pragma unroll
            for (int bj = 0; bj < 2; ++bj) { const int c = c0 + bj * HALF; float ya[8]; unpk8(bj == 0 ? yc0 : yc1, ya);
                const f32x4 b0 = bg[bj][0], b1 = bg[bj][1]; f32x4 o0, o1;
#pragma unroll
                for (int j = 0; j < 4; ++j) { o0[j] = ya[j] * sigmoidf_(acc[ai][bj][m][0][j] * WSC_INV + b0[j]); o1[j] = ya[4 + j] * sigmoidf_(acc[ai][bj][m][1][j] * WSC_INV + b1[j]); ss += o0[j] * o0[j] + o1[j] * o1[j]; }
                *(u32x4*)(MIX + (size_t)r * D + c) = pk8(o0, o1); }
            ss += __shfl_xor(ss, 16); ss += __shfl_xor(ss, 32);
            if (fq == 0) unsafeAtomicAdd(rss + r, ss);
            asm volatile("" ::: "memory"); }
#undef EG_LOAD
    }
};
struct EpiOut {
    const float* x; f16* out; f16* X16; const float* vec; float* rsx; const float* rss; const float* rsa2;
    __device__ __forceinline__ float r_s(int r) const { return __builtin_amdgcn_rsqf(rss[r] * (1.0f / D_SSM) + EPS); }
    __device__ __forceinline__ float r_a(int r) const { return __builtin_amdgcn_rsqf((rsa2[2 * r] + rsa2[2 * r + 1]) * (1.0f / D_ATTN) + EPS); }
    __device__ __forceinline__ void mid(f32x4 (&acc)[2][2][4][2], const Unit& u, int wr, int wc, int fr, int fq) const {
        const int row0 = u.pm * BM + wr * 64 + fr;
#pragma unroll
        EPI_ROWS(ai, m) { const int r = row0 + ai * HALF + m * 16;
            const float f = __builtin_amdgcn_rsqf(rss[r] * (1.0f / D_SSM) + EPS) * __builtin_amdgcn_sqrtf((rsa2[2 * r] + rsa2[2 * r + 1]) * (1.0f / D_ATTN) + EPS);
#pragma unroll
            for (int bj = 0; bj < 2; ++bj)
#pragma unroll
                for (int n = 0; n < 2; ++n) acc[ai][bj][m][n] *= f;
            asm volatile("" ::: "memory"); }
    }
    __device__ __forceinline__ void operator()(const f32x4 (&acc)[2][2][4][2], const Unit& u, int wr, int wc, int fr, int fq) const {
        const int row0 = u.pm * BM + wr * 64 + fr, c0 = u.pn * BM + wc * 32 + 8 * fq; const float* vb = vec + (u.pm >= 32 ? 6 * D : 0);
        f32x4 gav[2][2], csv[2][2];
#pragma unroll
        for (int bj = 0; bj < 2; ++bj)
#pragma unroll
            for (int n = 0; n < 2; ++n) { gav[bj][n] = *(const f32x4*)(vb + 0 * D + c0 + bj * HALF + 4 * n); csv[bj][n] = *(const f32x4*)(vb + 1 * D + c0 + bj * HALF + 4 * n); }
        f32x4 xn[2][2]; float qa0, qa1;
#define EO_LOAD(ri_) do { const int r_ = row0 + ((ri_) >> 2) * HALF + ((ri_) & 3) * 16; qa0 = rsa2[2 * r_]; qa1 = rsa2[2 * r_ + 1]; \
            _Pragma("unroll") for (int bj = 0; bj < 2; ++bj) _Pragma("unroll") for (int n = 0; n < 2; ++n) xn[bj][n] = *(const f32x4*)(x + (size_t)r_ * D + c0 + bj * HALF + 4 * n); } while (0)
        EO_LOAD(0);
#pragma unroll
        for (int ri = 0; ri < 8; ++ri) { const int ai = ri >> 2, m = ri & 3; const int r = row0 + ai * HALF + m * 16; float ss = 0.f;
            f32x4 xc[2][2]; const float ra = __builtin_amdgcn_rsqf((qa0 + qa1) * (1.0f / D_ATTN) + EPS) * WSC_INV;
#pragma unroll
            for (int bj = 0; bj < 2; ++bj)
#pragma unroll
                for (int n = 0; n < 2; ++n) xc[bj][n] = xn[bj][n];
            if (ri + 1 < 8) EO_LOAD(ri + 1);
            asm volatile("" ::: "memory");
#pragma unroll
            for (int bj = 0; bj < 2; ++bj) { const int c = c0 + bj * HALF; const size_t off = (size_t)r * D + c;
                f32x4 x1[2]; u32x2 q8;
#pragma unroll
                for (int n = 0; n < 2; ++n) { const f32x4 ga = gav[bj][n];
                    x1[n] = xc[bj][n] + ga * (acc[ai][bj][m][n] * ra); ss += x1[n][0] * x1[n][0] + x1[n][1] * x1[n][1] + x1[n][2] * x1[n][2] + x1[n][3] * x1[n][3];
                    const f32x4 cs = csv[bj][n]; const f32x4 xs = x1[n] * cs; const unsigned q = pk4i8(xs[0], xs[1], xs[2], xs[3], XA8_S); if (n == 0) q8.x = q; else q8.y = q; }
                *(u32x4*)(out + off) = pk8(x1[0], x1[1]);
                *(u32x2*)((char*)X16 + off) = q8; }
            ss += __shfl_xor(ss, 16); ss += __shfl_xor(ss, 32);
            if (fq == 0) unsafeAtomicAdd(rsx + r, ss);
            asm volatile("" ::: "memory"); }
#undef EO_LOAD
    }
};
constexpr float SQH = 3.2596012026f;
struct EpiUp {
    f16* HFF; const float* bias2; const float* rsx;
    __device__ __forceinline__ void operator()(const f32x4 (&acc)[2][2][4][2], const Unit& u, int wr, int wc, int fr, int fq) const {
        const int row0 = u.pm * BM + wr * 64 + fr, c0 = u.pn * BM + wc * 64 + 16 * fq; const float* bb = bias2 + (u.pm >= 32 ? D_FF : 0);
        f32x4 bv[2][2];
#pragma unroll
        for (int bj = 0; bj < 2; ++bj)
#pragma unroll
            for (int n = 0; n < 2; ++n) bv[bj][n] = *(const f32x4*)(bb + c0 + 8 * bj + 4 * n) * SQH;
#pragma unroll
        EPI_ROWS(ai, m) { const int r = row0 + ai * HALF + m * 16; const float rs = __builtin_amdgcn_rsqf(rsx[r] * (1.0f / D) + EPS) * (SQH / (XA8_S * WU8_S)); u32x4 w;
#pragma unroll
            for (int bj = 0; bj < 2; ++bj) { const i32x4 a0 = __builtin_bit_cast(i32x4, acc[ai][bj][m][0]), a1 = __builtin_bit_cast(i32x4, acc[ai][bj][m][1]);
                f32x4 v0 = (f32x4){(float)a0[0], (float)a0[1], (float)a0[2], (float)a0[3]} * rs + bv[bj][0], v1 = (f32x4){(float)a1[0], (float)a1[1], (float)a1[2], (float)a1[3]} * rs + bv[bj][1];
#pragma unroll
                for (int j = 0; j < 4; ++j) { v0[j] = fmaxf(v0[j], 0.f); v1[j] = fmaxf(v1[j], 0.f); }
                v0 = v0 * v0; v1 = v1 * v1;
                const unsigned q0 = pk4u8m128(v0[0], v0[1], v0[2], v0[3], 1.0f), q1 = pk4u8m128(v1[0], v1[1], v1[2], v1[3], 1.0f);
                if (bj == 0) { w.x = q0; w.y = q1; } else { w.z = q0; w.w = q1; } }
            *(u32x4*)((char*)HFF + (size_t)r * D_FF + c0) = w; }
    }
};
struct EpiDown {
    float* out; const f16* x1h; const float* vec; const float* csum;
    __device__ __forceinline__ void operator()(const f32x4 (&acc)[2][2][4][2], const Unit& u, int wr, int wc, int fr, int fq) const {
        const int row0 = u.pm * BM + wr * 64 + fr, c0 = u.pn * BM + wc * 32 + 8 * fq; const float* vb = vec + (u.pm >= 32 ? 6 * D : 0);
        f32x4 gm[2][2];
#pragma unroll
        for (int bj = 0; bj < 2; ++bj)
#pragma unroll
            for (int n = 0; n < 2; ++n) gm[bj][n] = *(const f32x4*)(vb + 3 * D + c0 + bj * HALF + 4 * n) * (1.0f / (H8_S * WD8_S));
        f32x4 cs4[2][2];
#pragma unroll
        for (int bj = 0; bj < 2; ++bj)
#pragma unroll
            for (int n = 0; n < 2; ++n) cs4[bj][n] = *(const f32x4*)(csum + c0 + bj * HALF + 4 * n) * 128.0f;
        u32x4 hn[2];
#define ED_LOAD(ri_) do { const int r_ = row0 + ((ri_) >> 2) * HALF + ((ri_) & 3) * 16; hn[0] = *(const u32x4*)(x1h + (size_t)r_ * D + c0); hn[1] = *(const u32x4*)(x1h + (size_t)r_ * D + c0 + HALF); } while (0)
        ED_LOAD(0);
#pragma unroll
        for (int ri = 0; ri < 8; ++ri) { const int ai = ri >> 2, m = ri & 3; const int r = row0 + ai * HALF + m * 16;
            const u32x4 hc0 = hn[0], hc1 = hn[1];
            if (ri + 1 < 8) ED_LOAD(ri + 1);
            asm volatile("" ::: "memory");
#pragma unroll
            for (int bj = 0; bj < 2; ++bj)
            { const size_t off = (size_t)r * D + c0 + bj * HALF; float xh[8]; unpk8(bj == 0 ? hc0 : hc1, xh);
#pragma unroll
                for (int n = 0; n < 2; ++n) { const i32x4 ai4 = __builtin_bit_cast(i32x4, acc[ai][bj][m][n]);
                    *(f32x4*)(out + off + 4 * n) = (f32x4){xh[4 * n], xh[4 * n + 1], xh[4 * n + 2], xh[4 * n + 3]} + gm[bj][n] * ((f32x4){(float)ai4[0], (float)ai4[1], (float)ai4[2], (float)ai4[3]} + cs4[bj][n]); } }
            asm volatile("" ::: "memory"); }
#undef ED_LOAD
    }
};
struct EpiDry { float* sink;
    __device__ __forceinline__ void operator()(const f32x4 (&acc)[2][2][4][2], const Unit& u, int wr, int wc, int fr, int fq) const {
        float s = 0.f;
#pragma unroll
        for (int ai = 0; ai < 2; ++ai)
#pragma unroll
            for (int bj = 0; bj < 2; ++bj)
#pragma unroll
                for (int m = 0; m < 4; ++m)
#pragma unroll
                    for (int n = 0; n < 2; ++n) s += acc[ai][bj][m][n][0] + acc[ai][bj][m][n][3];
        if (s == 123456.789f) sink[u.pm] = s; } };
}

struct Args {
    const float* in[25]; float* out; unsigned char* ws;
    double inv16[16]; double inv8[8];
    int ph_lo, ph_hi;
};
constexpr int NWAVES = 8, NPH = 11;

struct Frame {
    LAS unsigned char* lds; int tid, lane, wave, G, bx, gw, NGW;
    unsigned char* ws;
};

__device__ __forceinline__ void p0_transpose_item(const float* W, int K, int N, f16* WT, LAS float* scr, int item, int nblk, int lane, const float* g0 = nullptr, const float* g1 = nullptr) {
    const int kb = item / nblk, nb = item % nblk, k0 = 64 * kb, n0 = 32 * nb; const int nn = n0 + (lane & 31);
    float tv[32];
#pragma unroll
    for (int i = 0; i < 32; ++i) { const int kk = 2 * i + (lane >> 5); tv[i] = nn < N ? W[(size_t)(k0 + kk) * N + nn] : 0.f; }
#pragma unroll
    for (int i = 0; i < 32; ++i) { const int kk = 2 * i + (lane >> 5); float gg = 1.0f; if (g0) { const int k = k0 + kk; gg = k < 1024 ? g0[k] : g1[k - 1024]; } scr[kk * 33 + (lane & 31)] = tv[i] * gg; }
    LDS_WAIT(); asm volatile("" ::: "memory");
    const int c = lane & 7;
#pragma unroll
    for (int j = 0; j < 4; ++j) { const int n = (lane >> 3) + 8 * j; const LAS float* s = scr + (8 * c) * 33 + n;
        u32x4 o; o.x = pkh(s[0 * 33] * WSC, s[1 * 33] * WSC); o.y = pkh(s[2 * 33] * WSC, s[3 * 33] * WSC); o.z = pkh(s[4 * 33] * WSC, s[5 * 33] * WSC); o.w = pkh(s[6 * 33] * WSC, s[7 * 33] * WSC);
        *(GAS u32x4*)(WT + (size_t)(n0 + n) * K + k0 + 8 * c) = o; }
    LDS_WAIT(); asm volatile("" ::: "memory");
}
__device__ __forceinline__ void p0_transpose_item_i8(const float* W, int K, int N, signed char* WT, LAS float* scr, int item, int nblk, int lane, const float SC) {
    const int kb = item / nblk, nb = item % nblk, k0 = 64 * kb, n0 = 32 * nb; const int nn = n0 + (lane & 31);
    float tv[32];
#pragma unroll
    for (int i = 0; i < 32; ++i) { const int kk = 2 * i + (lane >> 5); tv[i] = W[(size_t)(k0 + kk) * N + nn]; }
#pragma unroll
    for (int i = 0; i < 32; ++i) { const int kk = 2 * i + (lane >> 5); scr[kk * 33 + (lane & 31)] = tv[i]; }
    LDS_WAIT(); asm volatile("" ::: "memory");
    const int c = lane & 3;
#pragma unroll
    for (int j = 0; j < 2; ++j) { const int n = (lane >> 2) + 16 * j; const LAS float* s = scr + (16 * c) * 33 + n;
        u32x4 o; o.x = pk4i8(s[0 * 33], s[1 * 33], s[2 * 33], s[3 * 33], SC); o.y = pk4i8(s[4 * 33], s[5 * 33], s[6 * 33], s[7 * 33], SC); o.z = pk4i8(s[8 * 33], s[9 * 33], s[10 * 33], s[11 * 33], SC); o.w = pk4i8(s[12 * 33], s[13 * 33], s[14 * 33], s[15 * 33], SC);
        *(GAS u32x4*)(WT + (size_t)(n0 + n) * K + k0 + 16 * c) = o; }
    LDS_WAIT(); asm volatile("" ::: "memory");
}
__device__ __forceinline__ void p0_tables(const Frame& F, const Args& a, int g) {
    LAS float* pwr = (LAS float*)F.lds; LAS float* pwi = pwr + 33 * 64; LAS float* Bbr = pwi + 33 * 64; LAS float* Bbi = Bbr + 1024; LAS float* Ccr = Bbi + 1024; LAS float* Cci = Ccr + 1024; LAS float* Kd = Cci + 1024;
    const float *lam_re = a.in[7], *lam_im = a.in[8], *log_dt = a.in[9], *b_re = a.in[10], *b_im = a.in[11], *c_re = a.in[12], *c_im = a.in[13];
    float* lamT = (float*)(F.ws + WS_SMALL) + SM_LAMT;
    if (F.tid < 64) {
        const int p = F.tid; const double dt = dexp((double)log_dt[g]); const double lr = (double)fminf(lam_re[g * SP + p], -1e-4f), li = (double)lam_im[g * SP + p];
        const double mag = dexp(lr * dt); double sn, cs; dsincos(li * dt, sn, cs); const double ar = mag * cs, ai = mag * sn;
        const double den = lr * lr + li * li; const double fr_ = ((ar - 1.0) * lr + ai * li) / den, fi_ = (ai * lr - (ar - 1.0) * li) / den;
        double pr = 1.0, pi = 0.0;
#pragma unroll 1
        for (int d = 0; d <= 32; ++d) { pwr[d * 64 + p] = (float)pr; pwi[d * 64 + p] = (float)pi; const double nr = pr * ar - pi * ai, ni = pr * ai + pi * ar; pr = nr; pi = ni; }
        lamT[(g * 64 + p) * 2 + 0] = pwr[32 * 64 + p]; lamT[(g * 64 + p) * 2 + 1] = pwi[32 * 64 + p];
#pragma unroll 1
        for (int h = 0; h < 16; ++h) { const double br = (double)b_re[(g * SP + p) * SG + h], bi = (double)b_im[(g * SP + p) * SG + h]; Bbr[p * 16 + h] = (float)(fr_ * br - fi_ * bi); Bbi[p * 16 + h] = (float)(fr_ * bi + fi_ * br); }
    }
    for (int i = F.tid; i < 1024; i += 512) { Ccr[i] = c_re[g * 1024 + i]; Cci[i] = c_im[g * 1024 + i]; }
    __syncthreads();
    {
        const int pr = F.tid & 255, h = pr >> 4, hp = pr & 15, dh = (F.tid >> 8) * 16; float kacc[16];
#pragma unroll
        for (int dd = 0; dd < 16; ++dd) kacc[dd] = 0.f;
#pragma unroll 2
        for (int p = 0; p < 64; ++p) { const float cr = Ccr[h * 64 + p], ci_ = Cci[h * 64 + p], br = Bbr[p * 16 + hp], bi = Bbi[p * 16 + hp]; const float zr = cr * br - ci_ * bi, zi = cr * bi + ci_ * br;
#pragma unroll
            for (int dd = 0; dd < 16; ++dd) kacc[dd] += zr * pwr[(dh + dd) * 64 + p] - zi * pwi[(dh + dd) * 64 + p]; }
#pragma unroll
        for (int dd = 0; dd < 16; ++dd) Kd[((dh + dd) * 16 + h) * 16 + hp] = kacc[dd];
    }
    __syncthreads();
    f16* T1 = (f16*)(F.ws + WS_T1) + (size_t)g * 768 * 512;
    for (int q = F.tid; q < 640 * 64; q += 512) { const int n = q >> 6, kc = q & 63, j = kc >> 1, h0 = (kc & 1) * 8; float v[8];
        if (n < 512) { const int t = n >> 4, h = n & 15;
#pragma unroll
            for (int e = 0; e < 8; ++e) v[e] = (j <= t) ? Kd[((t - j) * 16 + h) * 16 + h0 + e] * TSC : 0.f;
        } else if (n < 640) { const int e_ = n - 512, p = e_ & 63, part = e_ >> 6, d = 31 - j; const float lr_ = pwr[d * 64 + p], li_ = pwi[d * 64 + p];
#pragma unroll
            for (int e = 0; e < 8; ++e) { const float br = Bbr[p * 16 + h0 + e], bi = Bbi[p * 16 + h0 + e]; v[e] = (part == 0 ? (lr_ * br - li_ * bi) : (lr_ * bi + li_ * br)) * TSC; }
        } else {
#pragma unroll
            for (int e = 0; e < 8; ++e) v[e] = 0.f; }
        u32x4 o; o.x = pkh(v[0], v[1]); o.y = pkh(v[2], v[3]); o.z = pkh(v[4], v[5]); o.w = pkh(v[6], v[7]);
        *(GAS u32x4*)(T1 + (size_t)n * 512 + kc * 8) = o; }
    f16* WY = (f16*)(F.ws + WS_WY) + (size_t)g * 512 * 256;
    for (int q = F.tid; q < 512 * 16; q += 512) { const int n = q >> 4, kc = q & 15, t = n >> 4, h = n & 15; float v[8];
#pragma unroll
        for (int e = 0; e < 8; ++e) { const int k = kc * 8 + e;
            if (k < 64) { v[e] = (Ccr[h * 64 + k] * pwr[(t + 1) * 64 + k] - Cci[h * 64 + k] * pwi[(t + 1) * 64 + k]) * WSC; }
            else if (k < 128) { const int p = k - 64; v[e] = -(Ccr[h * 64 + p] * pwi[(t + 1) * 64 + p] + Cci[h * 64 + p] * pwr[(t + 1) * 64 + p]) * WSC; }
            else v[e] = 0.f; }
        u32x4 o; o.x = pkh(v[0], v[1]); o.y = pkh(v[2], v[3]); o.z = pkh(v[4], v[5]); o.w = pkh(v[6], v[7]);
        *(GAS u32x4*)(WY + (size_t)n * 256 + kc * 8) = o; }
    __syncthreads();
}
struct CvItem { const float* W; unsigned char* WT; const float* g0; const float* g1; int N, K, k0, n0, i8; float sc; };
constexpr int CV_IN8 = (D / 64) * 10, CV_IN = (D / 64) * 5, CV_GLU = (D_SSM / 64) * (D_SSM / 256), CV_OUT = (D / 64) * (D / 256), CV_UP = (D / 64) * (D_FF / 256), CV_DN = (D_FF / 64) * (D / 256);
constexpr int CV_NITEMS = CV_IN8 + CV_IN + CV_GLU + CV_OUT + CV_UP + CV_DN;
struct CvSrc { const float *w_in, *w_glu, *w_out, *w_up, *w_dn, *g_s, *g_a; };
__device__ __forceinline__ CvItem cv_decode(const CvSrc& a, unsigned char* ws, int r) {
    CvItem c; c.g0 = nullptr; c.g1 = nullptr;
    if (r < CV_IN8) { c.W = a.w_in; c.WT = ws + WS_WIN8; c.N = D_IN; c.K = D; c.k0 = 64 * (r / 10); c.n0 = 256 * (r % 10); c.i8 = 1; c.sc = WU8_S; return c; } r -= CV_IN8;
    if (r < CV_IN) { c.W = a.w_in; c.WT = ws + WS_WIN; c.N = D_IN; c.K = D; c.k0 = 64 * (r / 5); c.n0 = 2560 + 256 * (r % 5); c.i8 = 0; c.sc = WSC; return c; } r -= CV_IN;
    if (r < CV_GLU) { c.W = a.w_glu; c.WT = ws + WS_WGLU; c.N = D_SSM; c.K = D_SSM; c.k0 = 64 * (r / 4); c.n0 = 256 * (r % 4); c.i8 = 0; c.sc = WSC; return c; } r -= CV_GLU;
    if (r < CV_OUT) { c.W = a.w_out; c.WT = ws + WS_WOUT; c.N = D; c.K = D; c.k0 = 64 * (r / 8); c.n0 = 256 * (r % 8); c.i8 = 0; c.sc = WSC; c.g0 = a.g_s; c.g1 = a.g_a; return c; } r -= CV_OUT;
    if (r < CV_UP) { c.W = a.w_up; c.WT = ws + WS_WUP; c.N = D_FF; c.K = D; c.k0 = 64 * (r / 32); c.n0 = 256 * (r % 32); c.i8 = 1; c.sc = WU8_S; return c; } r -= CV_UP;
    c.W = a.w_dn; c.WT = ws + WS_WDN; c.N = D; c.K = D_FF; c.k0 = 64 * (r / 8); c.n0 = 256 * (r % 8); c.i8 = 1; c.sc = WD8_S; return c;
}
__device__ __forceinline__ void p0_prologue(const Frame& F, const Args& a) {
    if (F.bx >= NG) {
        const float* c = a.in[1]; const float* w_ada = a.in[3]; float* modp = (float*)(F.ws + WS_SMALL) + SM_MODP;
        LAS float* sil = (LAS float*)(F.lds + RING_BYTES);
        for (int i = F.tid; i < 2 * D; i += 512) { const float cv = c[i]; sil[i] = cv * sigmoidf_(cv); }
        __syncthreads();
        const int item = F.bx - NG, kq = item / 48, cb = item % 48, r0 = kq * 512 + F.wave * 64;
        const float* wp = w_ada + (size_t)r0 * (N_MOD * D) + cb * 256 + 4 * F.lane;
        f32x4 a0 = {0.f, 0.f, 0.f, 0.f}, a1 = {0.f, 0.f, 0.f, 0.f};
#pragma unroll 1
        for (int k0 = 0; k0 < 64; k0 += 16) { f32x4 wv_[16];
#pragma unroll
            for (int j = 0; j < 16; ++j) wv_[j] = *(const f32x4*)(wp + (size_t)(k0 + j) * (N_MOD * D));
#pragma unroll
            for (int j = 0; j < 16; ++j) { const float s0 = sil[r0 + k0 + j], s1 = sil[D + r0 + k0 + j]; a0 += wv_[j] * s0; a1 += wv_[j] * s1; } }
        LAS float* red = (LAS float*)F.lds;
        *(LAS f32x4*)(red + (F.wave * 2 + 0) * 256 + 4 * F.lane) = a0; *(LAS f32x4*)(red + (F.wave * 2 + 1) * 256 + 4 * F.lane) = a1;
        __syncthreads();
        { const int bb = F.tid >> 8, col = F.tid & 255; float v = 0.f;
#pragma unroll
          for (int w8 = 0; w8 < 8; ++w8) v += red[(w8 * 2 + bb) * 256 + col];
          modp[(kq * 2 + bb) * (N_MOD * D) + cb * 256 + col] = v; }
        __syncthreads();
    }
    if (F.bx < NG) p0_tables(F, a, F.bx);
    {
        unsigned* qh = (unsigned*)(F.ws + WS_CTL) + CW_QH; volatile LAS unsigned* MQ = (volatile LAS unsigned*)(F.lds + MISC_OFF) + 16;
        const int lane = F.lane, w = F.wave; const CvSrc cs{a.in[6], a.in[15], a.in[21], a.in[23], a.in[24], a.in[19], a.in[20]};
#define CV_DMA(it_, buf_) do { const CvItem c_ = cv_decode(cs, F.ws, (int)(it_)); int col_ = c_.n0 + 4 * (lane ^ (2 * w)); if (col_ >= c_.N) col_ = c_.n0; \
        const float* src_ = c_.W + (size_t)(c_.k0 + 8 * w) * c_.N + col_; \
        _Pragma("unroll") for (int rr_ = 0; rr_ < 8; ++rr_) __builtin_amdgcn_global_load_lds((const unsigned*)(src_ + (size_t)rr_ * c_.N), (LAS unsigned*)(F.lds + (buf_) * 65536 + (8 * w + rr_) * 1024), 16, 0, 0); } while (0)
        unsigned cur = (unsigned)F.bx, nxt = (unsigned)(F.G + F.bx);
        if (cur < (unsigned)CV_NITEMS) CV_DMA(cur, 0);
#pragma unroll 1
        for (int i = 0; cur < (unsigned)CV_NITEMS; ++i) {
            asm volatile("s_waitcnt vmcnt(0)" ::: "memory"); __syncthreads();
            if (i > 0) nxt = MQ[(i - 1) & 1];
            if (nxt < (unsigned)CV_NITEMS) CV_DMA(nxt, (i + 1) & 1);
            if (F.tid == 0) MQ[i & 1] = __hip_atomic_fetch_add(qh, 1u, RLX_AGENT) + 2u * (unsigned)F.G;
            const CvItem c = cv_decode(cs, F.ws, (int)cur); const LAS unsigned char* buf = F.lds + (i & 1) * 65536;
            if (c.i8) { const int cc = lane & 3, nn = lane >> 2;
#pragma unroll
                for (int j = 0; j < 2; ++j) { const int ncol = 32 * w + 16 * j + nn; float v[16];
#pragma unroll
                    for (int e = 0; e < 16; ++e) { const int row = 16 * cc + e; v[e] = *(const LAS float*)(buf + row * 1024 + (((ncol >> 2) ^ (2 * (2 * cc + (e >> 3)))) << 4) + (ncol & 3) * 4); }
                    u32x4 o; o.x = pk4i8(v[0], v[1], v[2], v[3], c.sc); o.y = pk4i8(v[4], v[5], v[6], v[7], c.sc); o.z = pk4i8(v[8], v[9], v[10], v[11], c.sc); o.w = pk4i8(v[12], v[13], v[14], v[15], c.sc);
                    *(GAS u32x4*)(c.WT + (size_t)(c.n0 + ncol) * c.K + c.k0 + 16 * cc) = o; }
            } else { const int cc = lane & 7, nn = lane >> 3; float gg[8];
#pragma unroll
                for (int e = 0; e < 8; ++e) gg[e] = c.sc;
                if (c.g0) { const float* gp = (c.k0 < 1024 ? c.g0 + c.k0 : c.g1 + (c.k0 - 1024)) + 8 * cc;
#pragma unroll
                    for (int e = 0; e < 8; ++e) gg[e] *= gp[e]; }
#pragma unroll
                for (int j = 0; j < 4; ++j) { const int ncol = 32 * w + 8 * j + nn; const bool ok = c.n0 + ncol < c.N; float v[8];
#pragma unroll
                    for (int e = 0; e < 8; ++e) { const int row = 8 * cc + e; const float t = *(const LAS float*)(buf + row * 1024 + (((ncol >> 2) ^ (2 * cc)) << 4) + (ncol & 3) * 4); v[e] = ok ? t * gg[e] : 0.f; }
                    u32x4 o; o.x = pkh(v[0], v[1]); o.y = pkh(v[2], v[3]); o.z = pkh(v[4], v[5]); o.w = pkh(v[6], v[7]);
                    *(GAS u32x4*)(c.WT + ((size_t)(c.n0 + ncol) * c.K + c.k0 + 8 * cc) * 2) = o; }
            }
            cur = nxt; }
#undef CV_DMA
        asm volatile("s_waitcnt vmcnt(0)" ::: "memory"); __syncthreads();
    }
}

__device__ __forceinline__ void p1_norm(const Frame& F, const Args& a) {
    const int rows_per = M / F.G, r0 = F.bx * rows_per, b = r0 / SEQ;
    LAS float* sc = (LAS float*)F.lds; LAS float* sh = sc + D;
    const float* modp = (const float*)(F.ws + WS_SMALL) + SM_MODP; const float* b_ada = a.in[4]; float* vec = (float*)(F.ws + WS_SMALL) + SM_VEC + b * 6 * D;
    for (int i = F.tid; i < 2 * D; i += 512) { float v = b_ada[i];
#pragma unroll
        for (int kq = 0; kq < 4; ++kq) v += modp[(kq * 2 + b) * (N_MOD * D) + i];
        const int j = i / D, k = i % D;
        if (j == 0) sh[k] = v; else sc[k] = a.in[5][k] * (1.0f + v); }
    if (F.tid < 64) {
        const int e = ((r0 % SEQ) / rows_per) * 64 + F.tid, j = 2 + e / D, k = e % D, i = j * D + k; float v = b_ada[i];
#pragma unroll
        for (int kq = 0; kq < 4; ++kq) v += modp[(kq * 2 + b) * (N_MOD * D) + i];
        if (j == 2) vec[0 * D + k] = v; else if (j == 3) vec[2 * D + k] = v; else if (j == 4) vec[1 * D + k] = a.in[22][k] * (1.0f + v); else vec[3 * D + k] = v; }
    __syncthreads();
    const float* x = a.in[0]; f16* X16 = (f16*)(F.ws + WS_X16);
    for (int r = r0 + F.wave; r < r0 + rows_per; r += NWAVES) {
        const GAS f32x4* xr = (const GAS f32x4*)(x + (size_t)r * D) + F.lane; f32x4 v[8]; float s = 0.f;
#pragma unroll
        for (int j = 0; j < 8; ++j) { v[j] = xr[64 * j]; s += (v[j].x * v[j].x + v[j].y * v[j].y) + (v[j].z * v[j].z + v[j].w * v[j].w); }
        const float rstd = 1.0f / sqrtf(wave_sum(s) * (1.0f / D) + EPS);
        GAS u32x2* o = (GAS u32x2*)(X16 + (size_t)r * D) + F.lane;
#pragma unroll
        for (int j = 0; j < 8; ++j) { const int k = 4 * F.lane + 256 * j; const f32x4 s4 = *(const LAS f32x4*)(sc + k), h4 = *(const LAS f32x4*)(sh + k); const f32x4 y = v[j] * rstd * s4 + h4;
            u32x2 w; w.x = pkh(y.x, y.y); w.y = pkh(y.z, y.w); o[64 * j] = w;
            ((GAS unsigned*)((signed char*)(F.ws + WS_H8) + (size_t)r * D))[F.lane + 64 * j] = pk4i8(y.x, y.y, y.z, y.w, HA8_S); }
    }
    __syncthreads();
}

template <int DRY>
__device__ __forceinline__ void p3_post(const Frame& F, const Args& a) {
    const int* pos = (const int*)a.in[2]; const float *g_q = a.in[17], *g_k = a.in[18];
    f16* Q16 = (f16*)(F.ws + WS_Q16); f16* K16 = (f16*)(F.ws + WS_K16); float* QI32 = (float*)(F.ws + WS_QI32); const float* KW32 = (const float*)(F.ws + WS_KW32);
    f16* KI16 = (f16*)(F.ws + WS_KI16); float* WI32 = (float*)(F.ws + WS_WI32);
    const int lane = F.lane;
    float gq[16], gk[16];
#pragma unroll
    for (int j = 0; j < 16; ++j) { gq[j] = g_q[16 * (lane & 7) + j]; gk[j] = g_k[16 * (lane & 7) + j]; }
    for (int m = F.gw; m < M; m += F.NGW) {
        const float pf = (float)pos[m]; const int ai = lane & 31; const float invf = (float)(ai < 16 ? a.inv16[ai & 15] : a.inv8[ai & 7]); const float angf = pf * invf;
        double sn_, cs_; dsincos((double)angf, sn_, cs_); const float csl = (float)cs_, snl = (float)sn_;
        {
            f16* row = Q16 + (size_t)m * 1024 + 16 * lane; float v[16]; { float t0[8], t1[8]; unpk8(*(const u32x4*)row, t0); unpk8(*(const u32x4*)(row + 8), t1);
#pragma unroll
                for (int j = 0; j < 8; ++j) { v[j] = t0[j]; v[8 + j] = t1[j]; } }
            float ss = 0.f;
#pragma unroll
            for (int j = 0; j < 16; ++j) ss += v[j] * v[j];
            ss += __shfl_xor(ss, 1); ss += __shfl_xor(ss, 2); ss += __shfl_xor(ss, 4);
            const float rstd = 1.0f / sqrtf(ss * (1.0f / HD) + EPS);
#pragma unroll
            for (int j = 0; j < 16; ++j) v[j] = v[j] * rstd * gq[j];
            const int l8 = lane & 7;
#pragma unroll
            for (int j = 0; j < 16; ++j) { const float other = __shfl_xor(v[j], 1); const float cs = __shfl(csl, j), sn = __shfl(snl, j);
                if (l8 == 0) v[j] = v[j] * cs - other * sn; else if (l8 == 1) v[j] = other * sn + v[j] * cs; }
            u32x4 q8; q8.x = pk4i8(v[0], v[1], v[2], v[3]); q8.y = pk4i8(v[4], v[5], v[6], v[7]); q8.z = pk4i8(v[8], v[9], v[10], v[11]); q8.w = pk4i8(v[12], v[13], v[14], v[15]);
            asm volatile("s_waitcnt vmcnt(0)" ::: "memory");
            if (!DRY || pf < -1e30f) *(u32x4*)((char*)(Q16 + (size_t)m * 1024) + 16 * lane) = q8;
        }
        {
            const bool act = lane < 16; f16* row = K16 + (size_t)m * 256 + 16 * (lane & 15); float v[16]; { float t0[8], t1[8]; unpk8(*(const u32x4*)row, t0); unpk8(*(const u32x4*)(row + 8), t1);
#pragma unroll
                for (int j = 0; j < 8; ++j) { v[j] = t0[j]; v[8 + j] = t1[j]; } }
            float ss = 0.f;
#pragma unroll
            for (int j = 0; j < 16; ++j) ss += v[j] * v[j];
            ss += __shfl_xor(ss, 1); ss += __shfl_xor(ss, 2); ss += __shfl_xor(ss, 4);
            const float rstd = 1.0f / sqrtf(ss * (1.0f / HD) + EPS);
#pragma unroll
            for (int j = 0; j < 16; ++j) v[j] = v[j] * rstd * gk[j];
            const int l8 = lane & 7;
#pragma unroll
            for (int j = 0; j < 16; ++j) { const float other = __shfl_xor(v[j], 1); const float cs = __shfl(csl, j), sn = __shfl(snl, j);
                if (l8 == 0) v[j] = v[j] * cs - other * sn; else if (l8 == 1) v[j] = other * sn + v[j] * cs; }
            u32x4 k8; k8.x = pk4i8(v[0], v[1], v[2], v[3]); k8.y = pk4i8(v[4], v[5], v[6], v[7]); k8.z = pk4i8(v[8], v[9], v[10], v[11]); k8.w = pk4i8(v[12], v[13], v[14], v[15]);
            asm volatile("s_waitcnt vmcnt(0)" ::: "memory");
            if (act && (!DRY || pf < -1e30f)) *(u32x4*)((char*)(F.ws + WS_K8) + ((size_t)(lane >> 3) * M + m) * 128 + 16 * (lane & 7)) = k8;
        }
        {
            float cs8[8], sn8[8];
#pragma unroll
            for (int j = 0; j < 8; ++j) { cs8[j] = __shfl(csl, 16 + j); sn8[j] = __shfl(snl, 16 + j); }
            if ((lane & 3) == 0) {
                f16* orow = (f16*)QI32 + (size_t)m * 2048 + 16 * lane; float v[16]; { float t0[8], t1[8]; unpk8(*(const u32x4*)orow, t0); unpk8(*(const u32x4*)(orow + 8), t1);
#pragma unroll
                    for (int j = 0; j < 8; ++j) { v[j] = t0[j]; v[8 + j] = t1[j]; } }
#pragma unroll
                for (int j = 0; j < 8; ++j) { const float x1 = v[j], x2 = v[8 + j]; v[j] = x1 * cs8[j] - x2 * sn8[j]; v[8 + j] = x1 * sn8[j] + x2 * cs8[j]; }
                f32x4 o0 = {v[0], v[1], v[2], v[3]}, o1 = {v[4], v[5], v[6], v[7]}, o2 = {v[8], v[9], v[10], v[11]}, o3 = {v[12], v[13], v[14], v[15]};
                if (!DRY || pf < -1e30f) { *(u32x4*)orow = pk8(o0, o1); *(u32x4*)(orow + 8) = pk8(o2, o3); } }
            if (lane < 4) { const float* kr = KW32 + (size_t)m * 256 + 16 * lane; float kv[16];
#pragma unroll
                for (int j = 0; j < 16; ++j) kv[j] = kr[j];
                if (lane == 0) {
#pragma unroll
                    for (int j = 0; j < 8; ++j) { const float x1 = kv[j], x2 = kv[8 + j]; kv[j] = x1 * cs8[j] - x2 * sn8[j]; kv[8 + j] = x1 * sn8[j] + x2 * cs8[j]; } }
                f32x4 p0 = {kv[0], kv[1], kv[2], kv[3]}, p1 = {kv[4], kv[5], kv[6], kv[7]}, p2 = {kv[8], kv[9], kv[10], kv[11]}, p3 = {kv[12], kv[13], kv[14], kv[15]};
                f16* ko = KI16 + ((size_t)((m >> 5) * 4 + lane) * 64 + (m & 31)) * 8; if (!DRY || pf < -1e30f) { *(u32x4*)ko = pk8(p0, p1); *(u32x4*)(ko + 32 * 8) = pk8(p2, p3); } }
            if (lane < 16 && (!DRY || pf < -1e30f)) WI32[(size_t)m * 16 + lane] = KW32[(size_t)m * 256 + 64 + lane] * (1.0f / 32.0f);
        }
    }
    {
        const signed char* WUP = (const signed char*)(F.ws + WS_WUP); const float* vec = (const float*)(F.ws + WS_SMALL) + SM_VEC; float* bias2 = (float*)(F.ws + WS_SMALL) + SM_BIAS2;
        f32x4 sh0[2][4], sh1[2][4];
#pragma unroll
        for (int j = 0; j < 2; ++j)
#pragma unroll
            for (int q = 0; q < 4; ++q) { const int k = 16 * lane + 1024 * j + 4 * q; sh0[j][q] = *(const f32x4*)(vec + 2 * D + k); sh1[j][q] = *(const f32x4*)(vec + 6 * D + 2 * D + k); }
        u32x4 wn[2]; { const int n0 = F.gw < D_FF ? F.gw : 0; wn[0] = *(const u32x4*)(WUP + (size_t)n0 * D + 16 * lane); wn[1] = *(const u32x4*)(WUP + (size_t)n0 * D + 16 * lane + 1024); }
        for (int n = F.gw; n < D_FF; n += F.NGW) { float s0 = 0.f, s1 = 0.f;
            const u32x4 wc0 = wn[0], wc1 = wn[1];
            { const int nn = n + F.NGW < D_FF ? n + F.NGW : n; wn[0] = *(const u32x4*)(WUP + (size_t)nn * D + 16 * lane); wn[1] = *(const u32x4*)(WUP + (size_t)nn * D + 16 * lane + 1024); }
            asm volatile("" ::: "memory");
#pragma unroll
            for (int j = 0; j < 2; ++j) { const u32x4 wq = j == 0 ? wc0 : wc1;
#pragma unroll
                for (int e = 0; e < 16; ++e) { const unsigned wd = e < 4 ? wq.x : e < 8 ? wq.y : e < 12 ? wq.z : wq.w; const float w = (float)(int)(signed char)((wd >> (8 * (e & 3))) & 255u); s0 += w * sh0[j][e >> 2][e & 3]; s1 += w * sh1[j][e >> 2][e & 3]; } }
            s0 = wave_sum(s0); s1 = wave_sum(s1);
            if (lane == 0 && (!DRY || s0 == 123456.789f)) { bias2[n] = s0 * (1.0f / WU8_S); bias2[D_FF + n] = s1 * (1.0f / WU8_S); }
            asm volatile("" ::: "memory"); }
    }
    {
        const signed char* WDN = (const signed char*)(F.ws + WS_WDN); float* csum = (float*)(F.ws + WS_SMALL) + SM_CSUM;
        for (int n = F.gw; n < D; n += F.NGW) { int acc = 0;
#pragma unroll
            for (int j = 0; j < 8; ++j) { const u32x4 wq = *(const u32x4*)(WDN + (size_t)n * D_FF + 16 * lane + 1024 * j);
#pragma unroll
                for (int e = 0; e < 16; ++e) { const unsigned wd = e < 4 ? wq.x : e < 8 ? wq.y : e < 12 ? wq.z : wq.w; acc += (int)(signed char)((wd >> (8 * (e & 3))) & 255u); } }
#pragma unroll
            for (int o = 1; o < 64; o <<= 1) acc += __shfl_xor(acc, o);
            if (lane == 0 && (!DRY || acc == 123456789)) csum[n] = (float)acc; }
    }
}

__device__ __forceinline__ void p4_scan(const Frame& F) {
    if (F.bx >= 128) return;
    const int g = F.bx & 63, b = F.bx >> 6, p = F.lane, w = F.wave;
    const float* lamT = (const float*)(F.ws + WS_SMALL) + SM_LAMT; const float lr = lamT[(g * 64 + p) * 2], li = lamT[(g * 64 + p) * 2 + 1];
    const float* E = (const float*)(F.ws + WS_E32) + ((size_t)g * 512 + b * NCH + 32 * w) * 128; f16* SP_ = (f16*)(F.ws + WS_SPREV) + ((size_t)g * 512 + b * NCH + 32 * w) * 256;
    LAS float* tl = (LAS float*)F.lds;
    float er[32], ei[32];
#pragma unroll
    for (int j = 0; j < 32; ++j) { er[j] = E[(size_t)j * 128 + p]; ei[j] = E[(size_t)j * 128 + 64 + p]; }
    float sr = 0.f, si = 0.f;
#pragma unroll
    for (int j = 0; j < 32; ++j) { const float nr = lr * sr - li * si + er[j], ni = lr * si + li * sr + ei[j]; er[j] = sr; ei[j] = si; sr = nr; si = ni; }
    tl[(w * 2 + 0) * 64 + p] = sr; tl[(w * 2 + 1) * 64 + p] = si;
    float l32r = lr, l32i = li;
#pragma unroll
    for (int q = 0; q < 5; ++q) { const float nr = l32r * l32r - l32i * l32i, ni = 2.f * l32r * l32i; l32r = nr; l32i = ni; }
    __syncthreads();
    float cr = 0.f, ci = 0.f;
    for (int v = 0; v < w; ++v) { const float tr = tl[(v * 2 + 0) * 64 + p], ti = tl[(v * 2 + 1) * 64 + p]; const float nr = l32r * cr - l32i * ci + tr, ni = l32r * ci + l32i * cr + ti; cr = nr; ci = ni; }
#pragma unroll
    for (int j = 0; j < 32; ++j) { f16* row = SP_ + (size_t)j * 256; row[p] = (f16)(er[j] + cr); row[64 + p] = (f16)(ei[j] + ci);
        const float nr = lr * cr - li * ci, ni = lr * ci + li * cr; cr = nr; ci = ni; }
    asm volatile("s_waitcnt vmcnt(0)" ::: "memory");
    __syncthreads();
    if (F.tid == 0) { __builtin_amdgcn_fence(__ATOMIC_RELEASE, "agent"); asm volatile("s_waitcnt vmcnt(0)" ::: "memory"); (void)xb_add((unsigned*)(F.ws + WS_CTL) + CW_SCAN, 1u); }
}

constexpr int IX_QB = 32, IX_CAP = 512, IX_TRIG = IX_CAP - 64;
constexpr int IXL_CS = 0, IXL_CI = IX_QB * IX_CAP * 4, IXL_KT = IXL_CI + IX_QB * IX_CAP * 2, IXL_HIST = IXL_KT + 4 * 8192, IXL_FLAG = IXL_HIST + 8 * 512;
constexpr int IX_SOFT = 416, IX_MINC = 320;
static_assert(IXL_FLAG + 64 <= MISC_OFF, "indexer lds");
__device__ __forceinline__ unsigned f2key(float f) { const unsigned u = __builtin_bit_cast(unsigned, f); return (u & 0x80000000u) ? ~u : (u | 0x80000000u); }
__device__ __forceinline__ float key2f(unsigned k) { const unsigned u = (k & 0x80000000u) ? (k & 0x7fffffffu) : ~k; return __builtin_bit_cast(float, u); }
__device__ __forceinline__ int ix_select(LAS unsigned char* lds, int q, int lane, int n) {
    LAS float* cs = (LAS float*)(lds + IXL_CS) + q * IX_CAP; LAS u16* ci = (LAS u16*)(lds + IXL_CI) + q * IX_CAP;
    unsigned key[8]; unsigned idx[8];
#pragma unroll
    for (int i = 0; i < 8; ++i) { const int e = lane + 64 * i; const bool v = e < n; key[i] = v ? f2key(cs[e]) : 0u; idx[i] = v ? (unsigned)ci[e] : 0u; }
    unsigned T = 0u;
#pragma unroll 1
    for (int bit = 31; bit >= 0; --bit) { const unsigned cand = T | (1u << bit); int c = 0;
#pragma unroll
        for (int i = 0; i < 8; ++i) c += __popcll(__ballot(key[i] >= cand));
        if (c >= TOPK) T = cand; }
    int cgt = 0;
#pragma unroll
    for (int i = 0; i < 8; ++i) cgt += __popcll(__ballot(key[i] > T));
    int need = TOPK - cgt, base = 0;
    LDS_WAIT(); asm volatile("" ::: "memory");
#pragma unroll
    for (int i = 0; i < 8; ++i) {
        const bool gt = key[i] > T, eq = key[i] == T && T != 0u;
        const unsigned long long meq = __ballot(eq); const int eqrank = __popcll(meq & ((1ull << lane) - 1ull)); const bool take = gt || (eq && eqrank < need);
        const unsigned long long mt = __ballot(take); const int pos = base + __popcll(mt & ((1ull << lane) - 1ull));
        if (take) { cs[pos] = key2f(key[i]); ci[pos] = (u16)idx[i]; }
        base += __popcll(mt); const int teq = __popcll(meq); need -= teq < need ? teq : need;
    }
    LDS_WAIT(); asm volatile("" ::: "memory");
    return base;
}
#define DPP_ROW_SHR(n) (0x110 + (n))
#define DPP_ROW_ROR(n) (0x120 + (n))
__device__ __forceinline__ float dpp_rowf(float v, const int ctrl_unused) { return v; }
template <int CTRL> __device__ __forceinline__ int dpp_i(int v) { return __builtin_amdgcn_update_dpp(0, v, CTRL, 0xf, 0xf, true); }
template <int CTRL> __device__ __forceinline__ float dpp_f(float v) { return __builtin_bit_cast(float, __builtin_amdgcn_update_dpp(0, __builtin_bit_cast(int, v), CTRL, 0xf, 0xf, true)); }
__device__ __forceinline__ float wave_max_s(float v) {
    v = fmaxf(v, dpp_f<DPP_ROW_ROR(8)>(v)); v = fmaxf(v, dpp_f<DPP_ROW_ROR(4)>(v)); v = fmaxf(v, dpp_f<DPP_ROW_ROR(2)>(v)); v = fmaxf(v, dpp_f<DPP_ROW_ROR(1)>(v));
    const int iv = __builtin_bit_cast(int, v);
    const float a = __builtin_bit_cast(float, __builtin_amdgcn_readlane(iv, 0)), b = __builtin_bit_cast(float, __builtin_amdgcn_readlane(iv, 16)), c = __builtin_bit_cast(float, __builtin_amdgcn_readlane(iv, 32)), d = __builtin_bit_cast(float, __builtin_amdgcn_readlane(iv, 48));
    return fmaxf(fmaxf(a, b), fmaxf(c, d));
}
__device__ __forceinline__ float wave_min_s(float v) { return -wave_max_s(-v); }
__device__ __forceinline__ int wave_prefix_sum(int v, int lane) {
    v += dpp_i<DPP_ROW_SHR(1)>(v); v += dpp_i<DPP_ROW_SHR(2)>(v); v += dpp_i<DPP_ROW_SHR(4)>(v); v += dpp_i<DPP_ROW_SHR(8)>(v);
    const int r0 = __builtin_amdgcn_readlane(v, 15), r1 = __builtin_amdgcn_readlane(v, 31), r2 = __builtin_amdgcn_readlane(v, 47);
    return v + (lane >= 16 ? r0 : 0) + (lane >= 32 ? r1 : 0) + (lane >= 48 ? r2 : 0);
}
__device__ __forceinline__ int ix_compact(LAS unsigned char* lds, LAS int* hist, int q, int lane, int n, float& tau_out) {
    LAS float* cs = (LAS float*)(lds + IXL_CS) + q * IX_CAP; LAS u16* ci = (LAS u16*)(lds + IXL_CI) + q * IX_CAP;
    float v[8]; unsigned idx[8]; float vmin = INFINITY, vmax = -INFINITY;
#pragma unroll
    for (int i = 0; i < 8; ++i) { const int e = lane + 64 * i; const bool ok = e < n; v[i] = ok ? cs[e] : -INFINITY; idx[i] = ok ? (unsigned)ci[e] : 0u; if (ok) { vmin = fminf(vmin, v[i]); vmax = fmaxf(vmax, v[i]); } }
    vmin = wave_min_s(vmin); vmax = wave_max_s(vmax);
    const float range = vmax - vmin;
    bool okk = range > 0.f && range < 1e30f;
    int b1[8], b2[8]; int bs = 0, ss = 0;
    if (okk) {
        const float sc1 = 64.0f / range;
        hist[lane] = 0; hist[64 + lane] = 0;
#pragma unroll
        for (int i = 0; i < 8; ++i) { int bb = (int)((v[i] - vmin) * sc1); bb = bb > 63 ? 63 : bb; b1[i] = (lane + 64 * i < n) ? 63 - bb : 64; if (b1[i] < 64) __hip_atomic_fetch_add(hist + b1[i], 1, __ATOMIC_RELAXED, __HIP_MEMORY_SCOPE_WAVEFRONT); }
        LDS_WAIT(); asm volatile("" ::: "memory");
        const int h1 = hist[lane]; const int P1 = wave_prefix_sum(h1, lane);
        const unsigned long long m1 = __ballot(P1 >= TOPK); bs = __builtin_ctzll(m1);
        const int above = __builtin_amdgcn_readlane(P1 - h1, bs);
        const int hb = __builtin_amdgcn_readlane(h1, bs);
        ss = 63;
#pragma unroll
        for (int i = 0; i < 8; ++i) b2[i] = 0;
        int cnt_keep = above + hb;
        if (cnt_keep > IX_SOFT - 64) {
            const int need = TOPK - above;
            const float lo1 = vmin + (float)(63 - bs) / sc1; const float sc2 = sc1 * 64.0f;
#pragma unroll
            for (int i = 0; i < 8; ++i) { int bb = (int)((v[i] - lo1) * sc2); bb = bb < 0 ? 0 : (bb > 63 ? 63 : bb); b2[i] = 63 - bb; if (b1[i] == bs) __hip_atomic_fetch_add(hist + 64 + b2[i], 1, __ATOMIC_RELAXED, __HIP_MEMORY_SCOPE_WAVEFRONT); }
            LDS_WAIT(); asm volatile("" ::: "memory");
            const int h2 = hist[64 + lane]; const int P2 = wave_prefix_sum(h2, lane);
            const unsigned long long m2 = __ballot(P2 >= need); ss = __builtin_ctzll(m2);
            cnt_keep = above + __builtin_amdgcn_readlane(P2, ss);
        }
        okk = cnt_keep <= IX_SOFT - 64;
    }
    if (!okk) { const int nn = ix_select(lds, q, lane, n); float t = INFINITY;
#pragma unroll
        for (int i = 0; i < 4; ++i) { const int e = lane + 64 * i; if (e < nn) t = fminf(t, cs[e]); }
        tau_out = wave_min_s(t); return nn; }
    int base = 0; float tmin = INFINITY;
    LDS_WAIT(); asm volatile("" ::: "memory");
#pragma unroll
    for (int i = 0; i < 8; ++i) {
        const bool take = b1[i] < bs || (b1[i] == bs && b2[i] <= ss);
        const unsigned long long mt = __ballot(take); const int pos = base + __popcll(mt & ((1ull << lane) - 1ull));
        if (take) { cs[pos] = v[i]; ci[pos] = (u16)idx[i]; tmin = fminf(tmin, v[i]); }
        base += __popcll(mt);
    }
    LDS_WAIT(); asm volatile("" ::: "memory");
    tau_out = wave_min_s(tmin);
    return base;
}
template <int MODE>
__device__ __forceinline__ void p4_indexer(const Frame& F) {
    LAS unsigned char* lds = F.lds; const int lane = F.lane, w = F.wave;
    LAS float* cs = (LAS float*)(lds + IXL_CS); LAS u16* ci = (LAS u16*)(lds + IXL_CI); LAS int* hist = (LAS int*)(lds + IXL_HIST) + w * 128; volatile LAS int* flags = (volatile LAS int*)(lds + IXL_FLAG);
    const f16* QI16 = (const f16*)(F.ws + WS_QI32); const f16* KIF = (const f16*)(F.ws + WS_KI16); const float* WI32 = (const float*)(F.ws + WS_WI32); u16* SEL = (u16*)(F.ws + WS_SEL);
    const int nunits = BATCH * (SEQ / IX_QB);
    const int hl = lane >> 5, l31 = lane & 31;
    for (int ui = F.bx; ui < nunits; ui += F.G) {
        const int rnd = ui / F.G, idx = ui % F.G; const int b = idx & 1; const int jj = idx >> 1;
        const int nqb = SEQ / IX_QB; const int qb = (rnd & 1) ? jj : (nqb - 1 - jj);
        const int t0 = qb * IX_QB; const size_t mb = (size_t)b * SEQ;
        if (F.tid < 3) flags[F.tid] = 0;
        half8 Af[2][4]; f32x2 wv[2][8]; float tq[2]; int cn[4] = {0, 0, 0, 0};
        { const int mrow = l31, qs = (mrow >> 2) & 1, hd = 4 * (mrow >> 3) + (mrow & 3);
#pragma unroll
            for (int rt = 0; rt < 2; ++rt) { const size_t tok = mb + t0 + 4 * w + 2 * rt + qs; const f16* src = QI16 + tok * 2048 + hd * 64 + 8 * hl;
#pragma unroll
                for (int s = 0; s < 4; ++s) Af[rt][s] = *(const half8*)(src + 16 * s);
                const size_t tokw = mb + t0 + 4 * w + 2 * rt + hl;
#pragma unroll
                for (int i = 0; i < 8; ++i) wv[rt][i] = *(const f32x2*)(WI32 + tokw * 16 + 2 * i);
                tq[rt] = (MODE != 0 && MODE != 2) ? INFINITY : -INFINITY; }
#pragma unroll
            for (int rt = 0; rt < 2; ++rt) {
#pragma unroll
                for (int s = 0; s < 4; ++s) asm volatile("" : "+v"(Af[rt][s]));
#pragma unroll
                for (int i = 0; i < 8; ++i) asm volatile("" : "+v"(wv[rt][i])); } }
        const int npair = ((t0 + IX_QB - 1) / 32 + 2) / 2;
        const f16* kbase = KIF + (size_t)(b * (SEQ / 32)) * 4 * 64 * 8 + (size_t)F.tid * 8;
#define IX_DMA(tile) __builtin_amdgcn_global_load_lds((const unsigned*)(kbase + (size_t)(tile) * 4096), (LAS unsigned*)(lds + IXL_KT + ((tile) & 3) * 8192 + w * 1024), 16, 0, 0)
        LDS_WAIT(); __builtin_amdgcn_s_barrier();
        IX_DMA(0); if (npair > 1) IX_DMA(1); if (npair > 2) IX_DMA(2);
        if (npair > 2) asm volatile("s_waitcnt vmcnt(2)" ::: "memory"); else if (npair > 1) asm volatile("s_waitcnt vmcnt(1)" ::: "memory"); else asm volatile("s_waitcnt vmcnt(0)" ::: "memory");
        LDS_WAIT(); __builtin_amdgcn_s_barrier(); asm volatile("" ::: "memory");
        f32x16 accA[2], accB[2];
#define IX_MMA(ACC, BF) do { _Pragma("unroll") for (int rt = 0; rt < 2; ++rt) { ACC[rt] = (f32x16){}; \
            if (MODE == 3 || MODE == 5) { _Pragma("unroll") for (int i = 0; i < 16; ++i) ACC[rt][i] = (float)BF[i & 3][i >> 2] + (float)Af[rt][i & 3][i >> 2]; } \
            else { _Pragma("unroll") for (int s = 0; s < 4; ++s) ACC[rt] = __builtin_amdgcn_mfma_f32_32x32x16_f16(Af[rt][s], BF[s], ACC[rt], 0, 0, 0); } } } while (0)
#define IX_CALC(ACC, S0, S1) do { _Pragma("unroll") for (int rt = 0; rt < 2; ++rt) { \
            float sc = 0.f, sd = 0.f;     \
            _Pragma("unroll") for (int i = 0; i < 4; ++i) { const int a0 = __builtin_bit_cast(int, (float)ACC[rt][2 * i]), a1 = __builtin_bit_cast(int, (float)ACC[rt][2 * i + 1]), b0 = __builtin_bit_cast(int, (float)ACC[rt][8 + 2 * i]), b1 = __builtin_bit_cast(int, (float)ACC[rt][9 + 2 * i]); \
                const int m0 = a0 > 0 ? a0 : 0, m1 = a1 > 0 ? a1 : 0, n0 = b0 > 0 ? b0 : 0, n1 = b1 > 0 ? b1 : 0; \
                sc = __builtin_fmaf(__builtin_bit_cast(float, m0), wv[rt][i].x, sc); sd = __builtin_fmaf(__builtin_bit_cast(float, n0), wv[rt][4 + i].x, sd); asm("" : "+v"(sd));   \
                sc = __builtin_fmaf(__builtin_bit_cast(float, m1), wv[rt][i].y, sc); sd = __builtin_fmaf(__builtin_bit_cast(float, n1), wv[rt][4 + i].y, sd); asm("" : "+v"(sd)); } \
            sc += sd; \
            if (MODE == 4 || MODE == 5) sc = ACC[rt][0] + ACC[rt][7] + ACC[rt][15]; \
            if (rt == 0) S0 = sc; else S1 = sc; } } while (0)
#define IX_APPEND(RT, SC, KEY) do { const int rt = (RT); const int key = (KEY); const float sc = (SC); \
            const int ql = 4 * w + 2 * rt + hl; const int t = t0 + ql; \
            const bool cond = key <= t && sc > tq[rt]; \
            const unsigned long long mask = __ballot(cond); \
            if (mask != 0ull) { \
                const unsigned lo = (unsigned)mask, hi = (unsigned)(mask >> 32); \
                const unsigned mym = hl ? hi : lo; const int rank = __popc(mym & ((1u << l31) - 1u)); \
                const int base = hl ? cn[2 * rt + 1] : cn[2 * rt]; \
                if (cond) { const int pos = base + rank; cs[ql * IX_CAP + pos] = sc; ci[ql * IX_CAP + pos] = (u16)key; } \
                cn[2 * rt] += __popc(lo); cn[2 * rt + 1] += __popc(hi); } } while (0)
#define IX_INTERLEAVE() do { _Pragma("unroll") for (int i_ = 0; i_ < 8; ++i_) { __builtin_amdgcn_sched_group_barrier(0x008, 1, 0); __builtin_amdgcn_sched_group_barrier(0x002, 7, 0); } } while (0)
        for (int tp = 0; tp < npair; ++tp) {
            const int fl = flags[(tp + 2) % 3];
            if (F.tid == 0) flags[(tp + 1) % 3] = 0;
            if (fl != 0) {
#pragma unroll 1
                for (int qq = 0; qq < 4; ++qq) { const int c = qq == 0 ? cn[0] : qq == 1 ? cn[1] : qq == 2 ? cn[2] : cn[3];
                    if (c > IX_MINC) { float tau; const int nn = ix_compact(lds, hist, 4 * w + qq, lane, c, tau);
                        cn[0] = qq == 0 ? nn : cn[0]; cn[1] = qq == 1 ? nn : cn[1]; cn[2] = qq == 2 ? nn : cn[2]; cn[3] = qq == 3 ? nn : cn[3];
                        if (hl == (qq & 1)) { tq[0] = (qq >> 1) == 0 ? tau : tq[0]; tq[1] = (qq >> 1) == 1 ? tau : tq[1]; } } } }
            if (tp + 3 < npair) IX_DMA(tp + 3);
            const LAS unsigned char* kb = lds + IXL_KT + (tp & 3) * 8192 + lane * 16;
            {
                half8 Bf0[4], Bf1[4]; float sB0 = 0.f, sB1 = 0.f, sA0, sA1;
#pragma unroll
                for (int s = 0; s < 4; ++s) Bf0[s] = *(const LAS half8*)(kb + s * 1024);
#pragma unroll
                for (int s = 0; s < 4; ++s) Bf1[s] = *(const LAS half8*)(kb + (4 + s) * 1024);
                if (tp > 0) { IX_MMA(accA, Bf0); IX_CALC(accB, sB0, sB1); IX_INTERLEAVE(); asm volatile("" : "+v"(sB0), "+v"(sB1));
                    IX_APPEND(0, sB0, (2 * tp - 1) * 32 + l31); IX_APPEND(1, sB1, (2 * tp - 1) * 32 + l31); }
                else { IX_MMA(accA, Bf0); }
                IX_MMA(accB, Bf1); IX_CALC(accA, sA0, sA1); IX_INTERLEAVE(); asm volatile("" : "+v"(sA0), "+v"(sA1));
                IX_APPEND(0, sA0, (2 * tp) * 32 + l31); IX_APPEND(1, sA1, (2 * tp) * 32 + l31); }
            if ((cn[0] > IX_SOFT || cn[1] > IX_SOFT || cn[2] > IX_SOFT || cn[3] > IX_SOFT) && lane == 0) flags[tp % 3] = 1;
            if (tp + 3 < npair) asm volatile("s_waitcnt vmcnt(2)" ::: "memory"); else if (tp + 2 < npair) asm volatile("s_waitcnt vmcnt(1)" ::: "memory"); else asm volatile("s_waitcnt vmcnt(0)" ::: "memory");
            LDS_WAIT(); __builtin_amdgcn_s_barrier(); asm volatile("" ::: "memory");
        }
        { float sB0, sB1; IX_CALC(accB, sB0, sB1); IX_APPEND(0, sB0, (2 * npair - 1) * 32 + l31); IX_APPEND(1, sB1, (2 * npair - 1) * 32 + l31); }
#undef IX_DMA
#undef IX_MMA
#undef IX_CALC
#undef IX_APPEND
#undef IX_INTERLEAVE
        if (MODE == 0)
#pragma unroll 1
        for (int qq = 0; qq < 4; ++qq) { const int q = 4 * w + qq; int n = qq == 0 ? cn[0] : qq == 1 ? cn[1] : qq == 2 ? cn[2] : cn[3]; if (n > TOPK) n = ix_select(lds, q, lane, n);
            LDS_WAIT(); u16* dst = SEL + (mb + t0 + q) * TOPK;
#pragma unroll
            for (int i = 0; i < 4; ++i) { const int e = lane + 64 * i; dst[e] = e < n ? ci[q * IX_CAP + e] : (u16)0; } }
    }
    asm volatile("s_waitcnt vmcnt(0) lgkmcnt(0)" ::: "memory"); __syncthreads();
}

typedef short short4v __attribute__((ext_vector_type(4)));
typedef short short8v __attribute__((ext_vector_type(8)));
typedef int i32x2v __attribute__((ext_vector_type(2)));
constexpr int ATL_WAVE = 19968, ATL_SEL = 0, ATL_OST = 512, ATL_KST = 1536, ATL_VR = 3584;
static_assert(ATL_WAVE * NWAVES <= MISC_OFF, "attention lds");
template <int MODE>
__device__ __forceinline__ void p7_attn(const Frame& F, const Args& a) {
    const int lane = F.lane; LAS unsigned char* wl = F.lds + F.wave * ATL_WAVE;
    LAS u16* lsel = (LAS u16*)(wl + ATL_SEL); LAS unsigned char* ost = wl + ATL_OST; LAS unsigned char* vring = wl + ATL_VR;
    const unsigned kst = (unsigned)(__UINTPTR_TYPE__)(wl + ATL_KST);
    const f16* Q16 = (const f16*)(F.ws + WS_Q16); const f16* K16 = (const f16*)(F.ws + WS_K16); const f16* V16 = (const f16*)(F.ws + WS_V16); const u16* SEL = (const u16*)(F.ws + WS_SEL);
    f16* MIX = (f16*)(F.ws + WS_MIX);
    const int hq = lane & 15, kq = lane >> 4;
    const int g = F.bx & 1; const char* K8g = (const char*)(F.ws + WS_K8) + (size_t)g * M * 128; const char* V8g = (const char*)(F.ws + WS_V8) + (size_t)g * M * 128;
    const int bsel = (F.bx >> 1) & 1; const int gwh = (F.bx >> 2) * NWAVES + F.wave, NGH = (F.G >> 2) * NWAVES; float* rsa2 = (float*)(F.ws + WS_CTL) + CW_RSA2;
#define AT_RHO(i_) (8 * (i_) + (lane >> 3))
#define AT_DSLOT(i_) (16 * ((AT_RHO(i_) >> 2) & 3) + 4 * (AT_RHO(i_) >> 4) + (AT_RHO(i_) & 3))
#define AT_DSRC(i_) ((unsigned)((((lane & 7) ^ (AT_RHO(i_) & 7)) * 16)))
    unsigned tra[2]; int trx[2];
    { const int r_ = hq >> 1, c_ = lane & 1;
#pragma unroll
        for (int h = 0; h < 2; ++h) { const int R = 16 * kq + 8 * h + r_; trx[h] = R & 7; tra[h] = (unsigned)(128 * R + 8 * c_); } }
#define AT_DMA(c, buf) do { unsigned z_ = 0u; asm volatile("" : "+v"(z_));   \
        _Pragma("unroll") for (int i_ = 0; i_ < 8; ++i_) { const unsigned idx_ = ((i_ & 1) ? (dpk[c][i_ >> 1] >> 16) : (dpk[c][i_ >> 1] & 0xffffu)) + z_; \
        __builtin_amdgcn_global_load_lds((const unsigned*)(V8g + ((size_t)(mb + idx_) * 128 + AT_DSRC(i_))), (LAS unsigned*)(vring + (buf) * 8192 + i_ * 1024), 16, 0, 0); } } while (0)
    unsigned* aq = (unsigned*)(F.ws + WS_CTL) + CW_ATT + 64 * (g + 2 * bsel);
    for (int mi = gwh; mi < SEQ; ) {
        const int m = bsel * SEQ + mi; const int b = bsel, t = mi; const int nsel = t + 1 < TOPK ? t + 1 : TOPK; const size_t mb = (size_t)b * SEQ; unsigned nx_ = 0u;
        { unsigned lo8 = (unsigned)lane * 8u; asm volatile("" : "+v"(lo8));
          u32x2 sv = *(const u32x2*)((const char*)(SEL + (size_t)m * TOPK) + lo8);
          if (lane == 0) nx_ = __hip_atomic_fetch_add(aq, 1u, RLX_AGENT);
          if (MODE == 1) { sv.x = sv.x == 0xdeadbeefu ? 1u : 0u; sv.y = 0u; } *(LAS u32x2*)(lsel + 4 * lane) = sv; }
        LDS_WAIT(); asm volatile("" ::: "memory");
        unsigned dpk[4][4];
#pragma unroll
        for (int c = 0; c < 2; ++c)
#pragma unroll
            for (int i = 0; i < 4; ++i) dpk[c][i] = (unsigned)lsel[64 * c + AT_DSLOT(2 * i)] | ((unsigned)lsel[64 * c + AT_DSLOT(2 * i + 1)] << 16);
        unsigned kpk[16];
#pragma unroll
        for (int T = 0; T < 16; ++T) kpk[T] = (unsigned)lsel[16 * T + (lane >> 3)] | ((unsigned)lsel[16 * T + 8 + (lane >> 3)] << 16);
        LDS_WAIT(); asm volatile("" ::: "memory");
        AT_DMA(0, 0); AT_DMA(1, 1);
        i32x4 Bq[2];
#pragma unroll
        for (int s = 0; s < 2; ++s) { i32x4 z = {0, 0, 0, 0}; unsigned qlo = (unsigned)((4 * g + hq) * HD + 16 * kq); asm volatile("" : "+v"(qlo)); if (hq < 4) z = *(const i32x4*)((const char*)Q16 + (size_t)m * 2048 + 64 * s + qlo); Bq[s] = z; }
        f32x4 sc[16];
        const unsigned wr0 = kst + (unsigned)((lane >> 3) * 128 + (((lane & 7) ^ (lane >> 3)) * 16)), wr1 = wr0 + 1024u;
        const unsigned rd0 = kst + (unsigned)(hq * 128 + ((kq ^ (hq & 7)) * 16)), rd1 = kst + (unsigned)(hq * 128 + (((kq + 4) ^ (hq & 7)) * 16));
        i32x4 ka[2], kb[2];
        i32x4 kreg[16][2];
#pragma unroll
        for (int T = 0; T < 16; ++T) { const unsigned i0_ = kpk[T] & 0xffffu, i1_ = kpk[T] >> 16;
            kreg[T][0] = *(const i32x4*)(K8g + (mb + i0_) * 128 + 16 * (lane & 7)); kreg[T][1] = *(const i32x4*)(K8g + (mb + i1_) * 128 + 16 * (lane & 7)); }
#define AT_KSTAGE(T_, A0, A1) do { \
            asm volatile("ds_write_b128 %0, %1" :: "v"(wr0), "v"(kreg[T_][0])); asm volatile("ds_write_b128 %0, %1" :: "v"(wr1), "v"(kreg[T_][1])); \
            asm volatile("ds_read_b128 %0, %1" : "=v"(A0) : "v"(rd0)); asm volatile("ds_read_b128 %0, %1" : "=v"(A1) : "v"(rd1)); } while (0)
#define AT_QK(T_, A0, A1) do { i32x4 acc = {0, 0, 0, 0}; acc = __builtin_amdgcn_mfma_i32_16x16x64_i8(A0, Bq[0], acc, 0, 0, 0); acc = __builtin_amdgcn_mfma_i32_16x16x64_i8(A1, Bq[1], acc, 0, 0, 0); \
            constexpr float SCQK = 0.08838834764831845f / (QK8_S * QK8_S);     \
            sc[T_] = (f32x4){(float)acc[0] * SCQK, (float)acc[1] * SCQK, (float)acc[2] * SCQK, (float)acc[3] * SCQK}; } while (0)
        AT_KSTAGE(0, ka[0], ka[1]);
#pragma unroll
        for (int T = 0; T < 16; ++T) {
            if (T + 1 < 16) { if (T & 1) AT_KSTAGE(T + 1, ka[0], ka[1]); else AT_KSTAGE(T + 1, kb[0], kb[1]); }
            if (T & 1) { if (T + 1 < 16) asm volatile("s_waitcnt lgkmcnt(4)" : "+v"(kb[0]), "+v"(kb[1])); else asm volatile("s_waitcnt lgkmcnt(0)" : "+v"(kb[0]), "+v"(kb[1])); AT_QK(T, kb[0], kb[1]); }
            else { asm volatile("s_waitcnt lgkmcnt(4)" : "+v"(ka[0]), "+v"(ka[1])); AT_QK(T, ka[0], ka[1]); } }
#undef AT_KSTAGE
#undef AT_QK
#pragma unroll
        for (int c = 2; c < 4; ++c)
#pragma unroll
            for (int i = 0; i < 4; ++i) dpk[c][i] = (unsigned)lsel[64 * c + AT_DSLOT(2 * i)] | ((unsigned)lsel[64 * c + AT_DSLOT(2 * i + 1)] << 16);
        LDS_WAIT(); asm volatile("" ::: "memory");
        int lim = nsel - 4 * kq; asm volatile("" : "+v"(lim));
        float mx = -INFINITY;
#pragma unroll
        for (int T = 0; T < 16; ++T)
#pragma unroll
            for (int i = 0; i < 4; ++i) mx = fmaxf(mx, sc[T][i]);
        mx = fmaxf(mx, __shfl_xor(mx, 16)); mx = fmaxf(mx, __shfl_xor(mx, 32));
        unsigned p8[16]; int isum = 0;
#pragma unroll
        for (int T = 0; T < 16; ++T) { unsigned w = 0u;
#pragma unroll
            for (int i = 0; i < 4; ++i) { const float p = (16 * T + i < lim) ? __expf(sc[T][i] - mx) : 0.f; const int q = (int)__builtin_rintf(p * 127.0f); isum += q; w |= (unsigned)q << (8 * i); }
            p8[T] = w; }
        isum += __shfl_xor(isum, 16); isum += __shfl_xor(isum, 32);
        i32x4 oacc[8];
#pragma unroll
        for (int dt = 0; dt < 8; ++dt) oacc[dt] = (i32x4){0, 0, 0, 0};
        asm volatile("s_waitcnt vmcnt(0)" ::: "memory");
#pragma unroll
        for (int c = 0; c < 4; ++c) {
            if (c >= 2) { if (c < 3) asm volatile("s_waitcnt vmcnt(8)" ::: "memory"); else asm volatile("s_waitcnt vmcnt(0)" ::: "memory"); }
            const i32x4 pf = {(int)p8[4 * c], (int)p8[4 * c + 1], (int)p8[4 * c + 2], (int)p8[4 * c + 3]};
            const LAS unsigned char* vb = vring + (c & 1) * 8192;
#pragma unroll
            for (int dh = 0; dh < 2; ++dh) {
                i32x2v t0[4], t1[4];
#pragma unroll
                for (int d4 = 0; d4 < 4; ++d4) { const int dt = 4 * dh + d4;
                    t0[d4] = __builtin_amdgcn_ds_read_tr8_b64_v2i32((LAS i32x2v*)(vb + tra[0] + 16 * (dt ^ trx[0])));
                    t1[d4] = __builtin_amdgcn_ds_read_tr8_b64_v2i32((LAS i32x2v*)(vb + tra[1] + 16 * (dt ^ trx[1]))); }
                __builtin_amdgcn_sched_barrier(0);
#pragma unroll
                for (int d4 = 0; d4 < 4; ++d4) { const int dt = 4 * dh + d4; const i32x4 vf = {t0[d4][0], t0[d4][1], t1[d4][0], t1[d4][1]};
                    oacc[dt] = __builtin_amdgcn_mfma_i32_16x16x64_i8(pf, vf, oacc[dt], 0, 0, 0); }
            }
            if (c + 2 < 4) { LDS_WAIT(); asm volatile("" ::: "memory"); AT_DMA(c + 2, c & 1); }
            __builtin_amdgcn_sched_barrier(0);
        }
        float ss = 0.f;
#pragma unroll
        for (int i = 0; i < 4; ++i) { const float inv = 1.0f / (V8_S * (float)__shfl(isum, i));
#pragma unroll
            for (int dt = 0; dt < 8; ++dt) { const float o = (float)oacc[dt][i] * inv; if (kq == 0) { ss += o * o; *(LAS f16*)(ost + (i * HD + 16 * dt + hq) * 2) = (f16)o; } } }
        LDS_WAIT(); asm volatile("" ::: "memory");
        ss = wave_sum(ss);
        unsigned lo16 = (unsigned)lane * 16u; asm volatile("" : "+v"(lo16));
        const u32x4 ov = *(const LAS u32x4*)(ost + lo16);
        if (lane == 0 && (MODE == 0 || ss == 123456.789f)) rsa2[2 * m + g] = ss;
        if (MODE == 0 || ss == 123456.789f) *(u32x4*)(MIX + (size_t)m * D + D_SSM + 4 * g * HD + 8 * lane) = ov;
        LDS_WAIT(); asm volatile("" ::: "memory");
        mi = __builtin_amdgcn_readfirstlane((int)nx_) + NGH;
    }
#undef AT_DMA
#undef AT_RHO
#undef AT_DSLOT
#undef AT_DSRC
}
__device__ __forceinline__ void p7_ssmnorm(const Frame& F, const Args& a) {
    const int lane = F.lane; f16* MIX = (f16*)(F.ws + WS_MIX);
    {
        const float* rss = (const float*)(F.ws + WS_CTL) + CW_RSS; const float* g_os = a.in[19];
        for (int m = F.gw; m < M; m += F.NGW) { const float rstd = 1.0f / sqrtf(rss[m] * (1.0f / D_SSM) + EPS); f16* row = MIX + (size_t)m * D + 16 * lane;
            float v0[8], v1[8]; unpk8(*(const u32x4*)row, v0); unpk8(*(const u32x4*)(row + 8), v1);
            f32x4 o0, o1, o2, o3;
#pragma unroll
            for (int j = 0; j < 4; ++j) { o0[j] = v0[j] * rstd * g_os[16 * lane + j]; o1[j] = v0[4 + j] * rstd * g_os[16 * lane + 4 + j]; o2[j] = v1[j] * rstd * g_os[16 * lane + 8 + j]; o3[j] = v1[4 + j] * rstd * g_os[16 * lane + 12 + j]; }
            *(u32x4*)row = pk8(o0, o1); *(u32x4*)(row + 8) = pk8(o2, o3); }
    }
}

__global__ void __launch_bounds__(NWAVES * 64, 2) hymba_fwd(Args args) {
    extern __shared__ __attribute__((aligned(16))) unsigned char lds_raw[];
    Frame F; F.lds = (LAS unsigned char*)lds_raw; F.tid = threadIdx.x; F.lane = F.tid & 63; F.wave = __builtin_amdgcn_readfirstlane(F.tid >> 6);
    F.G = gridDim.x; F.bx = blockIdx.x; F.gw = F.bx * NWAVES + F.wave; F.NGW = F.G * NWAVES; F.ws = args.ws;
    volatile LAS unsigned* MISC = (volatile LAS unsigned*)(F.lds + MISC_OFF);
    if (F.tid < 64) MISC[F.tid] = 0u;
    __syncthreads();
    unsigned* ctl = (unsigned*)(F.ws + WS_CTL);
    XcdBarrier bar; bar.bar = ctl + CW_BAR; bar.x = 0; bar.st = nullptr;
    if (MK_N_LAUNCHES == 1) bar = xcd_barrier_post(ctl + CW_BAR, MISC + 8);
    const int lo = args.ph_lo, hi = args.ph_hi;
#ifndef PHMASK
#define PHMASK 0x7ff
#endif
#define IN(k) ((((PHMASK) >> (k)) & 1) && lo <= (k) && (k) < hi)
#define SEAM(k) do { if (IN(k) && IN((k) + 1)) xcd_barrier(bar); } while (0)
    using namespace pg8;
    LAS unsigned char* ring = F.lds;
    const Operand opnone{nullptr, 0, 0}; (void)opnone;

    if (IN(0)) { p0_prologue(F, args); } SEAM(0);
    if (IN(1)) { p1_norm(F, args); } SEAM(1);
    if (IN(2)) {
        const int big = F.bx < 192;
        {
            const Operand A{(const char*)(F.ws + WS_H8), 128, (size_t)HALF * D}, B{(const char*)(F.ws + WS_WIN8), 128, (size_t)HALF * D};
            RangeOrder S{M / BM, 0, big ? 3 * F.bx : 576 + (F.bx - 192), big ? 3 : 1, (size_t)BM * D, (size_t)BM * D};
            EpiProj E{(f16*)(F.ws + WS_U16), (f16*)(F.ws + WS_Q16), (f16*)(F.ws + WS_K16), (f16*)(F.ws + WS_V16), (float*)(F.ws + WS_QI32), (float*)(F.ws + WS_KW32), 1.0f / (HA8_S * WU8_S)};
            gemm_phase<false, true>(ring, A, B, D / 128, RowMajorOff{D / 2}, RowMajorOff{D / 2}, S, E);
        }
        {
            const Operand A{(const char*)(F.ws + WS_X16), 128, (size_t)HALF * D * 2}, B{(const char*)(F.ws + WS_WIN) + (size_t)2560 * D * 2, 128, (size_t)HALF * D * 2};
            RangeOrder S{M / BM, 10, big ? F.bx : 192 + 2 * (F.bx - 192), big ? 1 : 2, (size_t)BM * D * 2, (size_t)BM * D * 2};
            EpiProj E{(f16*)(F.ws + WS_U16), (f16*)(F.ws + WS_Q16), (f16*)(F.ws + WS_K16), (f16*)(F.ws + WS_V16), (float*)(F.ws + WS_QI32), (float*)(F.ws + WS_KW32), 0.f};
            gemm_phase(ring, A, B, D / BK, RowMajorOff{D}, RowMajorOff{D}, S, E);
        }
    } SEAM(2);
    if (IN(3)) {
        p3_post<0>(F, args);
        __syncthreads();
        const Operand A{(const char*)(F.ws + WS_U16), (size_t)4 * D_SSM * 2, (size_t)HALF * CT * D_SSM * 2}, B{(const char*)(F.ws + WS_T1), 128, (size_t)HALF * 512 * 2};
        EpiSsm1 E{(f16*)(F.ws + WS_YIN), (float*)(F.ws + WS_E32)};
        { OneUnit1 S{F.bx, (size_t)BM * CT * D_SSM * 2, (size_t)BM * 512 * 2, (size_t)SG * 2, (size_t)768 * 512 * 2}; gemm_phase<false, false, false, true>(ring, A, B, ((F.bx >> 1) & 1) ? 512 / BK : 256 / BK, UStrideOff{}, RowMajorOff{512}, S, E); }
        if (F.tid == 0) MISC[22] = xb_add(ctl + CW_G1Q, 1u);
        __syncthreads();
        { const unsigned id = MISC[22];
          if (id < 128u) { OneUnit1 S{256 + (int)id, (size_t)BM * CT * D_SSM * 2, (size_t)BM * 512 * 2, (size_t)SG * 2, (size_t)768 * 512 * 2}; gemm_phase<false, false, false, true>(ring, A, B, 512 / BK, UStrideOff{}, RowMajorOff{512}, S, E); } }
    } SEAM(3);
    if (IN(4)) { p4_scan(F); p4_indexer<0>(F);
    }
    if (IN(4) && IN(5)) {
        if (F.tid == 0) { unsigned* ctr = (unsigned*)(F.ws + WS_CTL) + CW_SCAN; XB_SPIN(xb_ld(ctr) < 128u, ctl + CW_BAR); __builtin_amdgcn_fence(__ATOMIC_ACQUIRE, "agent"); asm volatile("s_waitcnt vmcnt(0)" ::: "memory"); }
        __syncthreads();
    }
    if (IN(5)) {
        const Operand A{(const char*)(F.ws + WS_SPREV), 128, (size_t)HALF * 256 * 2}, B{(const char*)(F.ws + WS_WY), 128, (size_t)HALF * 256 * 2};
        EpiSsm2 E{(f16*)(F.ws + WS_YIN), (const f16*)(F.ws + WS_U16), args.in[14]};
        if (F.tid == 0) MISC[20] = xb_add(ctl + CW_G2Q, 1u);
        __syncthreads();
        { const unsigned id = MISC[20];
          if (id < 256u) { OneUnit2 S{(int)id, (size_t)BM * 256 * 2, (size_t)BM * 256 * 2, (size_t)512 * 256 * 2, (size_t)512 * 256 * 2}; gemm_phase(ring, A, B, 128 / BK, RowMajorOff{256}, RowMajorOff{256}, S, E);     } }
        if (F.tid == 0) MISC[21] = xb_add(ctl + CW_G2Q, 1u);
        __syncthreads();
        { const unsigned id = MISC[21];
          if (id < 256u) { OneUnit2 S{(int)id, (size_t)BM * 256 * 2, (size_t)BM * 256 * 2, (size_t)512 * 256 * 2, (size_t)512 * 256 * 2}; gemm_phase(ring, A, B, 128 / BK, RowMajorOff{256}, RowMajorOff{256}, S, E);     } }
    } SEAM(5);
    if (IN(6)) {
        const Operand A{(const char*)(F.ws + WS_YIN), 128, (size_t)HALF * D_SSM * 2}, B{(const char*)(F.ws + WS_WGLU), 128, (size_t)HALF * D_SSM * 2};
        RectOrder S; S.init(M, D_SSM, F.G, F.bx, (size_t)BM * D_SSM * 2, (size_t)BM * D_SSM * 2);
        EpiGlu E{(const f16*)(F.ws + WS_YIN), (f16*)(F.ws + WS_MIX), args.in[16], (float*)(F.ws + WS_CTL) + CW_RSS};
        gemm_phase(ring, A, B, D_SSM / BK, RowMajorOff{D_SSM}, RowMajorOff{D_SSM}, S, E);
    }
    if (IN(7)) { p7_attn<0>(F, args);
    } SEAM(7);
    if (IN(8)) {
        const Operand A{(const char*)(F.ws + WS_MIX), 128, (size_t)HALF * D * 2}, B{(const char*)(F.ws + WS_WOUT), 128, (size_t)HALF * D * 2};
        RectOrderK2 S; S.base.init(M, D, F.G, F.bx, (size_t)BM * D * 2, (size_t)BM * D * 2); S.khalf_bytes = (size_t)D_SSM * 2;
        EpiOut E{args.in[0], (f16*)(F.ws + WS_X1H), (f16*)(F.ws + WS_X16), (const float*)(F.ws + WS_SMALL) + SM_VEC, (float*)(F.ws + WS_CTL) + CW_RSX, (const float*)(F.ws + WS_CTL) + CW_RSS, (const float*)(F.ws + WS_CTL) + CW_RSA2};
        gemm_phase<true>(ring, A, B, D_SSM / BK, RowMajorOff{D}, RowMajorOff{D}, S, E);
    } SEAM(8);
    if (IN(9)) {
        const Operand A{(const char*)(F.ws + WS_X16), 128, (size_t)HALF * D}, B{(const char*)(F.ws + WS_WUP), 128, (size_t)8 * D};
        RectOrder S; S.init(M, D_FF, F.G, F.bx, (size_t)BM * D, (size_t)BM * D);
        EpiUp E{(f16*)(F.ws + WS_HFF), (const float*)(F.ws + WS_SMALL) + SM_BIAS2, (const float*)(F.ws + WS_CTL) + CW_RSX};
        gemm_phase<false, true, true>(ring, A, B, D / 128, RowMajorOff{D / 2}, RowMajorOff{D / 2}, S, E);
    } SEAM(9);
    if (IN(10)) {
        const Operand A{(const char*)(F.ws + WS_HFF), 128, (size_t)HALF * D_FF}, B{(const char*)(F.ws + WS_WDN), 128, (size_t)HALF * D_FF};
        RectOrder S; S.init(M, D, F.G, F.bx, (size_t)BM * D_FF, (size_t)BM * D_FF);
        EpiDown E{args.out, (const f16*)(F.ws + WS_X1H), (const float*)(F.ws + WS_SMALL) + SM_VEC, (const float*)(F.ws + WS_SMALL) + SM_CSUM};
        gemm_phase<false, true>(ring, A, B, D_FF / 128, RowMajorOff{D_FF / 2}, RowMajorOff{D_FF / 2}, S, E);
    }
#undef IN
#undef SEAM
}

extern "C" void kernel_launch(void* const* d_in, const int* in_sizes, int n_in, void* d_out, int out_size, void* d_ws, size_t ws_size, hipStream_t stream) {
    static int grid = 0;
    if (grid == 0) {
        if (n_in != 25 || out_size != M * D || ws_size < WS_END) { fprintf(stderr, "kernel_launch: unexpected shapes (n_in %d, out %d, ws %zu)\n", n_in, out_size, ws_size); grid = -1; return; }
        int dev = 0, cus = 0;
        if (hipGetDevice(&dev) != hipSuccess || hipDeviceGetAttribute(&cus, hipDeviceAttributeMultiprocessorCount, dev) != hipSuccess) { grid = -1; return; }
        if (hipFuncSetAttribute((const void*)hymba_fwd, hipFuncAttributeMaxDynamicSharedMemorySize, LDS_BYTES) != hipSuccess) { fprintf(stderr, "kernel_launch: hipFuncSetAttribute failed\n"); grid = -1; return; }
        int per_cu = 0;
        if (hipOccupancyMaxActiveBlocksPerMultiprocessor(&per_cu, (const void*)hymba_fwd, NWAVES * 64, LDS_BYTES) != hipSuccess || per_cu < 1) fprintf(stderr, "kernel_launch: occupancy query says %d\n", per_cu);
        (void)hipGetLastError();
        grid = cus;
        if (grid != 256) { fprintf(stderr, "kernel_launch: built for 256 CUs, found %d\n", cus); grid = -1; return; }
    }
    if (grid < 0) return;
    if (hipMemsetAsync((char*)d_ws + WS_CTL, 0, CTL_ZERO_BYTES, stream) != hipSuccess) return;
    Args a{};
    for (int i = 0; i < 25; ++i) a.in[i] = (const float*)d_in[i];
    a.out = (float*)d_out; a.ws = (unsigned char*)d_ws;
    for (int i = 0; i < 16; ++i) a.inv16[i] = (double)(float)std::pow(500000.0, -(double)i / 16.0);
    for (int i = 0; i < 8; ++i) a.inv8[i] = (double)(float)std::pow(500000.0, -(double)i / 8.0);
    if (MK_N_LAUNCHES == 1) { a.ph_lo = 0; a.ph_hi = NPH; hipLaunchKernelGGL(hymba_fwd, dim3(grid), dim3(NWAVES * 64), LDS_BYTES, stream, a); }
    else for (int p = 0; p < NPH; ++p) { a.ph_lo = p; a.ph_hi = p + 1; hipLaunchKernelGGL(hymba_fwd, dim3(grid), dim3(NWAVES * 64), LDS_BYTES, stream, a);
    }
}
```
